# Optimizing an MI355X kernel written in HIP

```python
import math, functools
import jax, jax.numpy as jnp
from jax import lax
import numpy as np

D_MODEL = 1024
BATCH = 16
SEQ = 4096
DEPTH = 2

HEAD_DIM = 64
NSA_Q_HEADS = 8
NSA_KV_HEADS = 2
NSA_GROUP = NSA_Q_HEADS // NSA_KV_HEADS
CMP_LEN = 32
CMP_STRIDE = 16
CMP_HIDDEN = 128
SEL_LEN = 64
SEL_TOP_N = 16
WINDOW = 512
ATTN_Q_BLOCK = 128
SEL_Q_BLOCK = 32
N_BRANCHES = 3
GMLP_GROUPS = 8
GMLP_HEAD_DIM = 64
GMLP_CHUNK = 128
CONV_WIDTH = 3
FFN_HIDDEN = -(-8 * D_MODEL // (3 * 256)) * 256

Q_DIM = NSA_Q_HEADS * HEAD_DIM
KV_DIM = NSA_KV_HEADS * HEAD_DIM
GATE_DIM = NSA_Q_HEADS * N_BRANCHES
GMLP_DIM = GMLP_GROUPS * GMLP_HEAD_DIM
IN0_DIM = Q_DIM + 6 * KV_DIM + GATE_DIM + 2 * GMLP_DIM
MIX0_DIM = Q_DIM + GMLP_DIM

ALPHA = (2 * DEPTH) ** 0.25
BETA = (8 * DEPTH) ** -0.25
N_EVEN = (DEPTH + 1) // 2
N_ODD = DEPTH // 2
LN_EPS = 1e-5
NEG_INF = -1e30
FORCE_SCORE = 1e4

kernel_name = "hybrid_nsa_gmlp_shortconv_deepnorm_adaln"


def layer_norm(x, g, b):
    xf = x.astype(jnp.float32)
    mu = jnp.mean(xf, axis=-1, keepdims=True)
    var = jnp.mean(jnp.square(xf - mu), axis=-1, keepdims=True)
    y = (xf - mu) * lax.rsqrt(var + LN_EPS)
    return (y * g.astype(jnp.float32) + b.astype(jnp.float32)).astype(x.dtype)


def masked_softmax(s, mask):
    s = jnp.where(mask, s.astype(jnp.float32), NEG_INF)
    return jax.nn.softmax(s, axis=-1) * mask


def ada_modulation(c, w, b):
    m = jax.nn.silu(c) @ w + b
    shift, scale, gate = jnp.split(m[:, None, :], 3, axis=-1)
    return shift, scale, gate


def residual_update(x, c, ada_w, ada_b, ln_g, ln_b, sublayer):
    shift, scale, gate = ada_modulation(c, ada_w, ada_b)
    out = sublayer(x * (1 + scale) + shift)
    return layer_norm(ALPHA * x + (1 + gate) * out, ln_g, ln_b)


def compress_blocks(kv, pos, w1, w2):
    b_, g_, s_, dk = kv.shape
    r = CMP_LEN // CMP_STRIDE
    ch = kv.reshape(b_, g_, s_ // CMP_STRIDE, CMP_STRIDE, dk)
    n_c = s_ // CMP_STRIDE - r + 1
    blk = jnp.concatenate([ch[:, :, i:i + n_c] for i in range(r)], axis=3)
    blk = (blk + pos).reshape(b_, g_, n_c, CMP_LEN * dk)
    return jax.nn.gelu(blk @ w1) @ w2


def nsa_attention(q, k_c, v_c, k_s, v_s, k_w, v_w, gates, cmp_pos, cmp_w1, cmp_w2):
    b_, g_, r_, s_, dk = q.shape
    q = q * dk ** -0.5
    kc = compress_blocks(k_c, cmp_pos[0], cmp_w1[0], cmp_w2[0])
    vc = compress_blocks(v_c, cmp_pos[1], cmp_w1[1], cmp_w2[1])
    n_cmp = kc.shape[2]
    n_sel = s_ // SEL_LEN
    top_n = min(SEL_TOP_N, n_sel)
    cmp_end = jnp.arange(n_cmp) * CMP_STRIDE + CMP_LEN - 1
    kk = jnp.arange(n_cmp)[:, None]
    jj = jnp.arange(n_sel)[None, :]
    cover = ((kk * CMP_STRIDE < (jj + 1) * SEL_LEN)
             & (kk * CMP_STRIDE + CMP_LEN > jj * SEL_LEN)).astype(jnp.float32)

    def cmp_block(i):
        q_blk = lax.dynamic_slice_in_dim(q, i * ATTN_Q_BLOCK, ATTN_Q_BLOCK, axis=3)
        qpos = i * ATTN_Q_BLOCK + jnp.arange(ATTN_Q_BLOCK)
        s = jnp.einsum('bgrqd,bgkd->bgrqk', q_blk, kc)
        mask = cmp_end[None, :] <= qpos[:, None]
        p = masked_softmax(s, mask)
        o = jnp.einsum('bgrqk,bgkd->bgrqd', p.astype(vc.dtype), vc)
        imp = jnp.einsum('bgqk,kj->bgqj', p.sum(axis=2), cover)
        cur = (qpos // SEL_LEN)[:, None]
        valid = jj * SEL_LEN <= qpos[:, None]
        forced = (jj == 0) | (jj == cur) | (jj == cur - 1)
        imp = jnp.where(forced, FORCE_SCORE, jnp.where(valid, imp, -FORCE_SCORE))
        _, idx = lax.top_k(imp, top_n)
        return o, idx.astype(jnp.int32)

    o_cmp, sel_idx = lax.map(cmp_block, jnp.arange(s_ // ATTN_Q_BLOCK))
    o_cmp = jnp.moveaxis(o_cmp, 0, 3).reshape(b_, g_, r_, s_, dk)
    sel_idx = jnp.moveaxis(sel_idx, 0, 2).reshape(b_, g_, s_, top_n)

    ks_blocks = k_s.reshape(b_, g_, n_sel, SEL_LEN, dk)
    vs_blocks = v_s.reshape(b_, g_, n_sel, SEL_LEN, dk)
    bi = jnp.arange(b_)[:, None, None, None]
    gi = jnp.arange(g_)[None, :, None, None]

    def sel_block(i):
        q_blk = lax.dynamic_slice_in_dim(q, i * SEL_Q_BLOCK, SEL_Q_BLOCK, axis=3)
        idx = lax.dynamic_slice_in_dim(sel_idx, i * SEL_Q_BLOCK, SEL_Q_BLOCK, axis=2)
        qpos = i * SEL_Q_BLOCK + jnp.arange(SEL_Q_BLOCK)
        kg = ks_blocks[bi, gi, idx].reshape(b_, g_, SEL_Q_BLOCK, top_n * SEL_LEN, dk)
        vg = vs_blocks[bi, gi, idx].reshape(b_, g_, SEL_Q_BLOCK, top_n * SEL_LEN, dk)
        kpos = (idx[..., None] * SEL_LEN + jnp.arange(SEL_LEN)).reshape(
            b_, g_, SEL_Q_BLOCK, top_n * SEL_LEN)
        mask = (kpos <= qpos[:, None])[:, :, None]
        s = jnp.einsum('bgrqd,bgqkd->bgrqk', q_blk, kg)
        p = masked_softmax(s, mask)
        return jnp.einsum('bgrqk,bgqkd->bgrqd', p.astype(vg.dtype), vg)

    o_sel = lax.map(sel_block, jnp.arange(s_ // SEL_Q_BLOCK))
    o_sel = jnp.moveaxis(o_sel, 0, 3).reshape(b_, g_, r_, s_, dk)

    kw_pad = jnp.pad(k_w, ((0, 0), (0, 0), (WINDOW, 0), (0, 0)))
    vw_pad = jnp.pad(v_w, ((0, 0), (0, 0), (WINDOW, 0), (0, 0)))
    span = ATTN_Q_BLOCK + WINDOW

    def win_block(i):
        start = i * ATTN_Q_BLOCK
        q_blk = lax.dynamic_slice_in_dim(q, start, ATTN_Q_BLOCK, axis=3)
        kb = lax.dynamic_slice_in_dim(kw_pad, start, span, axis=2)
        vb = lax.dynamic_slice_in_dim(vw_pad, start, span, axis=2)
        qpos = start + jnp.arange(ATTN_Q_BLOCK)
        kpos = start - WINDOW + jnp.arange(span)
        dist = qpos[:, None] - kpos[None, :]
        mask = (dist >= 0) & (dist < WINDOW) & (kpos >= 0)[None, :]
        s = jnp.einsum('bgrqd,bgkd->bgrqk', q_blk, kb)
        p = masked_softmax(s, mask)
        return jnp.einsum('bgrqk,bgkd->bgrqd', p.astype(vb.dtype), vb)

    o_win = lax.map(win_block, jnp.arange(s_ // ATTN_Q_BLOCK))
    o_win = jnp.moveaxis(o_win, 0, 3).reshape(b_, g_, r_, s_, dk)

    return gates[..., 0:1] * o_cmp + gates[..., 1:2] * o_sel + gates[..., 2:3] * o_win


def chunked_gmlp(u, v, norm_g, w_s, b_s):
    b_, s_, gm, dm = u.shape
    u = jax.nn.gelu(u)
    vf = jax.nn.gelu(v).astype(jnp.float32)
    mu = jnp.mean(vf, axis=-1, keepdims=True)
    var = jnp.mean(jnp.square(vf - mu), axis=-1, keepdims=True)
    v = ((vf - mu) * lax.rsqrt(var + LN_EPS) * norm_g.astype(jnp.float32)).astype(u.dtype)
    v = v.reshape(b_, s_ // GMLP_CHUNK, GMLP_CHUNK, gm, dm)
    causal = jnp.tril(jnp.ones((GMLP_CHUNK, GMLP_CHUNK), dtype=bool))
    w = jnp.where(causal, w_s, jnp.zeros_like(w_s))
    mixed = jnp.einsum('gts,bnsgd->bntgd', w, v) + b_s.T[:, :, None]
    return (u * mixed.reshape(b_, s_, gm, dm)).reshape(b_, s_, gm * dm)


def hybrid_mixer(h, w_in, cmp_pos, cmp_w1, cmp_w2, gmlp_norm_g, gmlp_ws, gmlp_bs, w_out):
    b_, s_, _ = h.shape
    sizes = [Q_DIM] + [KV_DIM] * 6 + [GATE_DIM, GMLP_DIM, GMLP_DIM]
    offsets = np.cumsum(sizes)[:-1].tolist()
    q, kc, vc, ks, vs, kw, vw, g, u, v = jnp.split(h @ w_in, offsets, axis=-1)
    q = q.reshape(b_, s_, NSA_KV_HEADS, NSA_GROUP, HEAD_DIM).transpose(0, 2, 3, 1, 4)
    kv = [t.reshape(b_, s_, NSA_KV_HEADS, HEAD_DIM).transpose(0, 2, 1, 3)
          for t in (kc, vc, ks, vs, kw, vw)]
    gates = jax.nn.sigmoid(g).reshape(b_, s_, NSA_KV_HEADS, NSA_GROUP, N_BRANCHES)
    gates = gates.transpose(0, 2, 3, 1, 4)
    o_nsa = nsa_attention(q, *kv, gates, cmp_pos, cmp_w1, cmp_w2)
    o_nsa = o_nsa.transpose(0, 3, 1, 2, 4).reshape(b_, s_, Q_DIM)
    o_gmlp = chunked_gmlp(u.reshape(b_, s_, GMLP_GROUPS, GMLP_HEAD_DIM),
                          v.reshape(b_, s_, GMLP_GROUPS, GMLP_HEAD_DIM),
                          gmlp_norm_g, gmlp_ws, gmlp_bs)
    return jnp.concatenate([o_nsa, o_gmlp], axis=-1) @ w_out


def short_conv_mixer(h, w_in, conv_w, w_out):
    b_gate, c_gate, z = jnp.split(h @ w_in, 3, axis=-1)
    y = lax.conv_general_dilated(
        c_gate * z, conv_w[:, None, :], window_strides=(1,),
        padding=[(CONV_WIDTH - 1, 0)], dimension_numbers=('NWC', 'WIO', 'NWC'),
        feature_group_count=conv_w.shape[-1])
    return (b_gate * y) @ w_out


def swiglu(h, w_in, w_out):
    gate, up = jnp.split(h @ w_in, 2, axis=-1)
    return (jax.nn.silu(gate) * up) @ w_out


def setup_inputs(seed: int = 0) -> dict:
    key = jax.random.key(seed)
    ks = jax.random.split(key, 24)
    f32 = jnp.float32
    nrm = lambda k, shape, s: jax.random.normal(k, shape, f32) * s
    D = D_MODEL
    return {
        "x": nrm(ks[0], (BATCH, SEQ, D), 1.0),
        "c": nrm(ks[1], (BATCH, D), 1.0),
        "ada_w": nrm(ks[2], (DEPTH, 2, D, 3 * D), 0.1 * D ** -0.5),
        "ada_b": nrm(ks[3], (DEPTH, 2, 3 * D), 0.01),
        "ln_g": 1.0 + nrm(ks[4], (DEPTH, 2, D), 0.01),
        "ln_b": nrm(ks[5], (DEPTH, 2, D), 0.01),
        "even_w_in": nrm(ks[6], (N_EVEN, D, IN0_DIM), D ** -0.5),
        "even_cmp_pos": nrm(ks[7], (N_EVEN, 2, CMP_LEN, HEAD_DIM), 0.02),
        "even_cmp_w1": nrm(ks[8], (N_EVEN, 2, CMP_LEN * HEAD_DIM, CMP_HIDDEN), (CMP_LEN * HEAD_DIM) ** -0.5),
        "even_cmp_w2": nrm(ks[9], (N_EVEN, 2, CMP_HIDDEN, HEAD_DIM), CMP_HIDDEN ** -0.5),
        "even_gmlp_norm_g": 1.0 + nrm(ks[10], (N_EVEN, GMLP_GROUPS, GMLP_HEAD_DIM), 0.01),
        "even_gmlp_ws": nrm(ks[11], (N_EVEN, GMLP_GROUPS, GMLP_CHUNK, GMLP_CHUNK), GMLP_CHUNK ** -0.5),
        "even_gmlp_bs": 1.0 + nrm(ks[12], (N_EVEN, GMLP_GROUPS, GMLP_CHUNK), 0.01),
        "even_w_out": nrm(ks[13], (N_EVEN, MIX0_DIM, D), BETA * MIX0_DIM ** -0.5),
        "odd_w_in": nrm(ks[14], (N_ODD, D, 3 * D), D ** -0.5),
        "odd_conv_w": nrm(ks[15], (N_ODD, CONV_WIDTH, D), CONV_WIDTH ** -0.5),
        "odd_w_out": nrm(ks[16], (N_ODD, D, D), BETA * D ** -0.5),
        "ffn_w_in": nrm(ks[17], (DEPTH, D, 2 * FFN_HIDDEN), D ** -0.5),
        "ffn_w_out": nrm(ks[18], (DEPTH, FFN_HIDDEN, D), BETA * FFN_HIDDEN ** -0.5),
    }


def reference(x, c, ada_w, ada_b, ln_g, ln_b, even_w_in, even_cmp_pos, even_cmp_w1,
              even_cmp_w2, even_gmlp_norm_g, even_gmlp_ws, even_gmlp_bs, even_w_out,
              odd_w_in, odd_conv_w, odd_w_out, ffn_w_in, ffn_w_out):
    for layer in range(DEPTH):
        j = layer // 2
        if layer % 2 == 0:
            mixer = functools.partial(
                hybrid_mixer, w_in=even_w_in[j], cmp_pos=even_cmp_pos[j],
                cmp_w1=even_cmp_w1[j], cmp_w2=even_cmp_w2[j],
                gmlp_norm_g=even_gmlp_norm_g[j], gmlp_ws=even_gmlp_ws[j],
                gmlp_bs=even_gmlp_bs[j], w_out=even_w_out[j])
        else:
            mixer = functools.partial(
                short_conv_mixer, w_in=odd_w_in[j], conv_w=odd_conv_w[j], w_out=odd_w_out[j])
        x = residual_update(x, c, ada_w[layer, 0], ada_b[layer, 0],
                            ln_g[layer, 0], ln_b[layer, 0], mixer)
        ffn = functools.partial(swiglu, w_in=ffn_w_in[layer], w_out=ffn_w_out[layer])
        x = residual_update(x, c, ada_w[layer, 1], ada_b[layer, 1],
                            ln_g[layer, 1], ln_b[layer, 1], ffn)
    return x
```

```cpp
#include <hip/hip_runtime.h>
#include <hip/hip_cooperative_groups.h>
#include <cstdio>
namespace cg = cooperative_groups;

#define DI __device__ __forceinline__
typedef unsigned short u16;
typedef short bf16x8 __attribute__((ext_vector_type(8)));
typedef float f32x16 __attribute__((ext_vector_type(16)));
typedef float f32x4 __attribute__((ext_vector_type(4)));
typedef float f32x2_t __attribute__((ext_vector_type(2)));
typedef __bf16 bf16x2_t __attribute__((ext_vector_type(2)));
typedef unsigned u32x4 __attribute__((ext_vector_type(4)));
typedef unsigned u32x2 __attribute__((ext_vector_type(2)));
#define MFMA(a, b, c) __builtin_amdgcn_mfma_f32_32x32x16_bf16((a), (b), (c), 0, 0, 0)

constexpr int NT_TOK = 65536;
constexpr int SEQ = 4096;
constexpr int DM = 1024;
constexpr int FF = 2816;
constexpr int LDP = 1664;
constexpr int NVT = 768;
constexpr float ALPHA_RES = 1.4142135623730951f;

constexpr size_t AL(size_t x) { return (x + 255) & ~(size_t)255; }
constexpr size_t WS_WT_IN0 = 0;
constexpr size_t WS_WT_OUT0 = WS_WT_IN0 + AL((size_t)2432 * 1024 * 2);
constexpr size_t WS_WT_FI0 = WS_WT_OUT0 + AL((size_t)1024 * 1024 * 2);
constexpr size_t WS_WT_FI1 = WS_WT_FI0 + AL((size_t)5632 * 1024 * 2);
constexpr size_t WS_WT_FO0 = WS_WT_FI1 + AL((size_t)5632 * 1024 * 2);
constexpr size_t WS_WT_FO1 = WS_WT_FO0 + AL((size_t)1024 * 2816 * 2);
constexpr size_t WS_WT_IN1 = WS_WT_FO1 + AL((size_t)1024 * 2816 * 2);
constexpr size_t WS_WT_OUT1 = WS_WT_IN1 + AL((size_t)3072 * 1024 * 2);
constexpr size_t WS_W1T = WS_WT_OUT1 + AL((size_t)1024 * 1024 * 2);
constexpr size_t WS_W2T = WS_W1T + AL((size_t)2 * 128 * 2048 * 2);
constexpr size_t WS_TRIL = WS_W2T + AL((size_t)2 * 64 * 128 * 2);
constexpr size_t WS_MOD = WS_TRIL + AL((size_t)8 * 128 * 128 * 2);
constexpr size_t WS_B1P = WS_MOD + AL((size_t)4 * 16 * 3072 * 4);
constexpr size_t WS_KCMP = WS_B1P + AL((size_t)2 * 16 * 128 * 4);
constexpr size_t WS_VCMPT = WS_KCMP + AL((size_t)32 * 256 * 64 * 2);
constexpr size_t WS_XY = WS_VCMPT + AL((size_t)32 * 64 * 256 * 2);
constexpr size_t WS_H = WS_XY + AL((size_t)NT_TOK * 1024 * 4);
constexpr size_t WS_MIX = WS_H + AL((size_t)NT_TOK * 1024 * 2);
constexpr size_t WS_P = WS_MIX + AL((size_t)NT_TOK * 1024 * 2);
constexpr size_t WS_PR = WS_P;
constexpr size_t WS_VT = WS_PR + AL((size_t)(NT_TOK + 16) * LDP * 2);
constexpr size_t WS_ACT = WS_P;
constexpr size_t WS_B1 = WS_P;
constexpr size_t WS_CZ = WS_B1 + AL((size_t)NT_TOK * 1024 * 2);
constexpr size_t WS_END = WS_P + AL((size_t)NT_TOK * 2816 * 2);

struct Params {
    const float* x; const float* c; const float* ada_w; const float* ada_b; const float* ln_g; const float* ln_b;
    const float* even_w_in; const float* cmp_pos; const float* cmp_w1; const float* cmp_w2;
    const float* gmlp_norm_g; const float* gmlp_ws; const float* gmlp_bs; const float* even_w_out;
    const float* odd_w_in; const float* odd_conv_w; const float* odd_w_out; const float* ffn_w_in; const float* ffn_w_out;
    float* out; unsigned char* ws;
};

DI unsigned cvtpk(float lo, float hi) { f32x2_t v = {lo, hi}; bf16x2_t b = __builtin_convertvector(v, bf16x2_t); return __builtin_bit_cast(unsigned, b); }
DI float bf2f(u16 v) { return __uint_as_float(((unsigned)v) << 16); }
DI float bflo(unsigned v) { return __uint_as_float(v << 16); }
DI float bfhi(unsigned v) { return __uint_as_float(v & 0xffff0000u); }
DI int crow(int i, int h) { return (i & 3) + 8 * (i >> 2) + 4 * h; }
DI float fexp2(float x) { return __builtin_amdgcn_exp2f(x); }
DI float sigmoidf_(float x) { return 1.f / (1.f + __expf(-x)); }
DI float siluf_(float x) { return x / (1.f + __expf(-x)); }
DI float geluf_(float x) {
    const float u = 1.5957691216057308f * (x + 0.044715f * x * x * x);
    return x / (1.f + __expf(-u));
}
DI float wave_sum(float v) {
#pragma unroll
    for (int o = 32; o >= 1; o >>= 1) v += __shfl_xor(v, o);
    return v;
}

template <bool TR>
DI void gemm_main(const u16* __restrict__ A, long lda, long akc, const u16* __restrict__ Bt, long ldb, int nk,
                  char* lds, f32x16 (&acc)[2][2]) {
    const int tid = threadIdx.x, lane = tid & 63, w = tid >> 6, wm = w >> 1, wn = w & 1, r = lane & 31, h = lane >> 5;
    const int lrow = tid >> 3, lc = tid & 7;
    const int soff = lrow * 128 + ((lc ^ ((lrow >> 1) & 7)) << 4);
    const u16* ag = A + (long)lrow * lda + lc * 8;
    const u16* bg = Bt + (long)lrow * ldb + lc * 8;
    u32x4 ra[4], rb[4];
#pragma unroll
    for (int i = 0; i < 4; ++i) {
        ra[i] = *(const u32x4*)(ag + (long)(32 * i) * lda);
        rb[i] = *(const u32x4*)(bg + (long)(32 * i) * ldb);
    }
#pragma unroll
    for (int i = 0; i < 4; ++i) {
        *(u32x4*)(lds + soff + i * 4096) = ra[i];
        *(u32x4*)(lds + 16384 + soff + i * 4096) = rb[i];
    }
    __syncthreads();
    const int sw = (r >> 1) & 7;
    const int arow = (wm * 64 + r) * 128, brow = (wn * 64 + r) * 128;
    for (int kt = 0; kt < nk; ++kt) {
        char* cur = lds + (kt & 1) * 32768;
        char* nxt = lds + ((kt + 1) & 1) * 32768;
        const bool more = (kt + 1 < nk);
        if (more) {
            const u16* ag2 = ag + (long)(kt + 1) * akc;
            const u16* bg2 = bg + (long)(kt + 1) * 64;
#pragma unroll
            for (int i = 0; i < 4; ++i) {
                ra[i] = *(const u32x4*)(ag2 + (long)(32 * i) * lda);
                rb[i] = *(const u32x4*)(bg2 + (long)(32 * i) * ldb);
            }
        }
#pragma unroll
        for (int ks = 0; ks < 4; ++ks) {
            const int co = ((ks * 2 + h) ^ sw) << 4;
            bf16x8 af[2], bfr[2];
#pragma unroll
            for (int i = 0; i < 2; ++i) {
                af[i] = *(const bf16x8*)(cur + arow + i * 4096 + co);
                bfr[i] = *(const bf16x8*)(cur + 16384 + brow + i * 4096 + co);
            }
#pragma unroll
            for (int mi = 0; mi < 2; ++mi)
#pragma unroll
                for (int ni = 0; ni < 2; ++ni)
                    acc[mi][ni] = TR ? MFMA(bfr[ni], af[mi], acc[mi][ni]) : MFMA(af[mi], bfr[ni], acc[mi][ni]);
        }
        if (more) {
#pragma unroll
            for (int i = 0; i < 4; ++i) {
                *(u32x4*)(nxt + soff + i * 4096) = ra[i];
                *(u32x4*)(nxt + 16384 + soff + i * 4096) = rb[i];
            }
        }
        __syncthreads();
    }
}

DI void zero_acc(f32x16 (&acc)[2][2]) {
#pragma unroll
    for (int a = 0; a < 2; ++a)
#pragma unroll
        for (int b = 0; b < 2; ++b)
#pragma unroll
            for (int i = 0; i < 16; ++i) acc[a][b][i] = 0.f;
}

DI int src_col(int kind, int p) {
    if (kind == 0) return p;
    if (kind == 1) {
        if (p < 896) return p;
        if (p < 1024) return p + 128;
        if (p < 1536) return p - 1024 + 1304;
        if (p < 1560) return p - 1536 + 1280;
        if (p < 1664) return -1;
        if (p < 1792) return p - 1664 + 896;
        if (p < 1920) return p - 1792 + 1152;
        return p - 1920 + 1816;
    }
    if (kind == 2) {
        const int tile = p >> 7, wq = (p >> 6) & 1, ni = (p >> 5) & 1, i = p & 31;
        return (ni ? FF : 0) + tile * 64 + wq * 32 + i;
    }
    if (p < 1024) return p;
    const int pp = p - 1024, tile = pp >> 7, wq = (pp >> 6) & 1, ni = (pp >> 5) & 1, i = pp & 31;
    return 1024 + (ni ? 1024 : 0) + tile * 64 + wq * 32 + i;
}

DI void transpose_tile(const float* __restrict__ src, u16* __restrict__ dst, int K, int ldn, int kind, int pt, int ktile, char* lds) {
    float* tile = (float*)lds;
    const int tid = threadIdx.x;
    const int nl = tid & 63, kq = tid >> 6;
    const int sc = src_col(kind, pt * 64 + nl);
    const int k0 = ktile * 64;
#pragma unroll
    for (int i = 0; i < 16; ++i) {
        const int kk = kq + 4 * i;
        tile[kk * 65 + nl] = (sc >= 0) ? src[(long)(k0 + kk) * ldn + sc] : 0.f;
    }
    __syncthreads();
    const int n = tid >> 2, part = tid & 3;
    unsigned pk[8];
#pragma unroll
    for (int j = 0; j < 8; ++j) pk[j] = cvtpk(tile[(part * 16 + 2 * j) * 65 + n], tile[(part * 16 + 2 * j + 1) * 65 + n]);
    u16* dp = dst + (long)(pt * 64 + n) * K + k0 + part * 16;
    *(u32x4*)dp = (u32x4){pk[0], pk[1], pk[2], pk[3]};
    *(u32x4*)(dp + 8) = (u32x4){pk[4], pk[5], pk[6], pk[7]};
    __syncthreads();
}

DI void phase0(const Params& p, char* lds) {
    const int tid = threadIdx.x;
    unsigned char* ws = p.ws;
    constexpr int N_ADA = 192, N_B1 = 32, N_TRIL = 64;
    constexpr int NJ = 12;
    const int jitems[NJ] = {38 * 16, 16 * 16, 88 * 16, 88 * 16, 16 * 44, 16 * 44, 48 * 16, 16 * 16, 2 * 32, 2 * 32, 1 * 2, 1 * 2};
    int total = N_ADA + N_B1 + N_TRIL;
#pragma unroll
    for (int j = 0; j < NJ; ++j) total += jitems[j];
    for (int it = blockIdx.x; it < total; it += gridDim.x) {
        if (it < N_ADA) {
            const int ls = it / 48, cgp = it % 48;
            float* sc = (float*)lds;
            for (int e = tid; e < 16384; e += 256) { const int b = e >> 10, k = e & 1023; sc[k * 16 + b] = siluf_(p.c[e]); }
            __syncthreads();
            const int col = cgp * 64 + (tid & 63), kq = tid >> 6;
            const float* W = p.ada_w + (size_t)ls * 1024 * 3072 + col;
            float acc[16];
#pragma unroll
            for (int b = 0; b < 16; ++b) acc[b] = 0.f;
#pragma unroll 4
            for (int k = kq * 256; k < kq * 256 + 256; ++k) {
                const float wv = W[(size_t)k * 3072];
                const f32x4* s4 = (const f32x4*)(sc + k * 16);
#pragma unroll
                for (int q = 0; q < 4; ++q) { const f32x4 s = s4[q]; acc[4 * q] += wv * s[0]; acc[4 * q + 1] += wv * s[1]; acc[4 * q + 2] += wv * s[2]; acc[4 * q + 3] += wv * s[3]; }
            }
            __syncthreads();
            float* red = (float*)lds;
#pragma unroll
            for (int b = 0; b < 16; ++b) red[(kq * 16 + b) * 64 + (tid & 63)] = acc[b];
            __syncthreads();
            float* mod = (float*)(ws + WS_MOD);
            for (int e = tid; e < 1024; e += 256) {
                const int b = e >> 6, cl = e & 63;
                const float v = red[(0 * 16 + b) * 64 + cl] + red[(1 * 16 + b) * 64 + cl] + red[(2 * 16 + b) * 64 + cl] + red[(3 * 16 + b) * 64 + cl];
                mod[((size_t)ls * 16 + b) * 3072 + cgp * 64 + cl] = v + p.ada_b[ls * 3072 + cgp * 64 + cl];
            }
            __syncthreads();
            continue;
        }
        int i2 = it - N_ADA;
        if (i2 < N_B1) {
            const int wh = i2 >> 4, ch = i2 & 15;
            const int col = tid & 127, half = tid >> 7;
            const float* pos = p.cmp_pos + wh * 2048 + ch * 128 + half * 64;
            const float* w1 = p.cmp_w1 + ((size_t)wh * 2048 + ch * 128 + half * 64) * 128 + col;
            float a = 0.f;
#pragma unroll 8
            for (int k = 0; k < 64; ++k) a += pos[k] * w1[(size_t)k * 128];
            float* red = (float*)lds;
            red[tid] = a;
            __syncthreads();
            if (tid < 128) ((float*)(ws + WS_B1P))[(wh * 16 + ch) * 128 + tid] = red[tid] + red[tid + 128];
            __syncthreads();
            continue;
        }
        i2 -= N_B1;
        if (i2 < N_TRIL) {
            u16* dst = (u16*)(ws + WS_TRIL);
            const int e0 = (i2 * 256 + tid) * 8;
            const int s0 = e0 & 127, t = (e0 >> 7) & 127;
            const f32x4 a = *(const f32x4*)(p.gmlp_ws + e0), b = *(const f32x4*)(p.gmlp_ws + e0 + 4);
            float v[8] = {a[0], a[1], a[2], a[3], b[0], b[1], b[2], b[3]};
#pragma unroll
            for (int j = 0; j < 8; ++j) if (s0 + j > t) v[j] = 0.f;
            *(u32x4*)(dst + e0) = (u32x4){cvtpk(v[0], v[1]), cvtpk(v[2], v[3]), cvtpk(v[4], v[5]), cvtpk(v[6], v[7])};
            continue;
        }
        i2 -= N_TRIL;
        int job = 0;
#pragma unroll
        for (int j = 0; j < NJ; ++j) { if (job == j && i2 >= jitems[j]) { i2 -= jitems[j]; job = j + 1; } }
        const float* src; u16* dst; int K, ldn, kind;
        switch (job) {
            case 0: src = p.even_w_in; dst = (u16*)(ws + WS_WT_IN0); K = 1024; ldn = 2328; kind = 1; break;
            case 1: src = p.even_w_out; dst = (u16*)(ws + WS_WT_OUT0); K = 1024; ldn = 1024; kind = 0; break;
            case 2: src = p.ffn_w_in; dst = (u16*)(ws + WS_WT_FI0); K = 1024; ldn = 5632; kind = 2; break;
            case 3: src = p.ffn_w_in + (size_t)1024 * 5632; dst = (u16*)(ws + WS_WT_FI1); K = 1024; ldn = 5632; kind = 2; break;
            case 4: src = p.ffn_w_out; dst = (u16*)(ws + WS_WT_FO0); K = 2816; ldn = 1024; kind = 0; break;
            case 5: src = p.ffn_w_out + (size_t)2816 * 1024; dst = (u16*)(ws + WS_WT_FO1); K = 2816; ldn = 1024; kind = 0; break;
            case 6: src = p.odd_w_in; dst = (u16*)(ws + WS_WT_IN1); K = 1024; ldn = 3072; kind = 3; break;
            case 7: src = p.odd_w_out; dst = (u16*)(ws + WS_WT_OUT1); K = 1024; ldn = 1024; kind = 0; break;
            case 8: src = p.cmp_w1; dst = (u16*)(ws + WS_W1T); K = 2048; ldn = 128; kind = 0; break;
            case 9: src = p.cmp_w1 + (size_t)2048 * 128; dst = (u16*)(ws + WS_W1T) + (size_t)128 * 2048; K = 2048; ldn = 128; kind = 0; break;
            case 10: src = p.cmp_w2; dst = (u16*)(ws + WS_W2T); K = 128; ldn = 64; kind = 0; break;
            default: src = p.cmp_w2 + 128 * 64; dst = (u16*)(ws + WS_W2T) + 64 * 128; K = 128; ldn = 64; kind = 0; break;
        }
        const int nkt = K / 64;
        transpose_tile(src, dst, K, ldn, kind, i2 / nkt, i2 % nkt, lds);
    }
}

DI void phase_mod_x(const Params& p) {
    const float* mod = (const float*)(p.ws + WS_MOD);
    u16* H = (u16*)(p.ws + WS_H);
    const size_t n8 = (size_t)NT_TOK * 1024 / 8;
    for (size_t e = (size_t)blockIdx.x * 256 + threadIdx.x; e < n8; e += (size_t)gridDim.x * 256) {
        const size_t idx = e * 8; const int col = (int)(idx & 1023); const int b = (int)(idx >> 22);
        const float* mb = mod + (size_t)b * 3072;
        const f32x4 x0 = *(const f32x4*)(p.x + idx), x1 = *(const f32x4*)(p.x + idx + 4);
        const f32x4 sh0 = *(const f32x4*)(mb + col), sh1 = *(const f32x4*)(mb + col + 4);
        const f32x4 sc0 = *(const f32x4*)(mb + 1024 + col), sc1 = *(const f32x4*)(mb + 1024 + col + 4);
        const f32x4 h0 = x0 * (sc0 + 1.f) + sh0, h1 = x1 * (sc1 + 1.f) + sh1;
        *(u32x4*)(H + idx) = (u32x4){cvtpk(h0[0], h0[1]), cvtpk(h0[2], h0[3]), cvtpk(h1[0], h1[1]), cvtpk(h1[2], h1[3])};
    }
}

DI void phase_gemm_in0(const Params& p, char* lds) {
    const u16* A = (const u16*)(p.ws + WS_H);
    const u16* Bt = (const u16*)(p.ws + WS_WT_IN0);
    u16* PR = (u16*)(p.ws + WS_PR);
    u16* VT = (u16*)(p.ws + WS_VT);
    const int lane = threadIdx.x & 63, w = threadIdx.x >> 6, wm = w >> 1, wn = w & 1, r = lane & 31, h = lane >> 5;
    constexpr int MT = 512, NTL = 19;
    for (int tile = blockIdx.x; tile < MT * NTL; tile += gridDim.x) {
        const int mt = tile / NTL, nt = tile % NTL;
        f32x16 acc[2][2]; zero_acc(acc);
        const u16* Ab = A + (size_t)mt * 128 * 1024;
        const u16* Bb = Bt + (size_t)nt * 128 * 1024;
        if (nt < 13) {
            gemm_main<true>(Ab, 1024, 64, Bb, 1024, 16, lds, acc);
#pragma unroll
            for (int mi = 0; mi < 2; ++mi) {
                u16* rowp = PR + (size_t)(mt * 128 + wm * 64 + mi * 32 + r) * LDP + nt * 128 + wn * 64 + 4 * h;
#pragma unroll
                for (int ni = 0; ni < 2; ++ni)
#pragma unroll
                    for (int a = 0; a < 4; ++a)
                        *(u32x2*)(rowp + ni * 32 + 8 * a) = (u32x2){cvtpk(acc[mi][ni][4 * a], acc[mi][ni][4 * a + 1]), cvtpk(acc[mi][ni][4 * a + 2], acc[mi][ni][4 * a + 3])};
            }
        } else {
            gemm_main<false>(Ab, 1024, 64, Bb, 1024, 16, lds, acc);
            const int b = mt >> 5, t0 = (mt & 31) * 128;
#pragma unroll
            for (int ni = 0; ni < 2; ++ni) {
                const int ch = (nt - 13) * 128 + wn * 64 + ni * 32 + r;
                u16* chp = VT + ((size_t)b * NVT + ch) * SEQ + t0 + wm * 64 + 4 * h;
#pragma unroll
                for (int mi = 0; mi < 2; ++mi)
#pragma unroll
                    for (int a = 0; a < 4; ++a)
                        *(u32x2*)(chp + mi * 32 + 8 * a) = (u32x2){cvtpk(acc[mi][ni][4 * a], acc[mi][ni][4 * a + 1]), cvtpk(acc[mi][ni][4 * a + 2], acc[mi][ni][4 * a + 3])};
            }
        }
    }
}

DI void phase_gemm_res(const Params& p, char* lds, const u16* A, int K, const u16* Bt, const float* X, int ls) {
    float* XY = (float*)(p.ws + WS_XY);
    const float* mod = (const float*)(p.ws + WS_MOD) + (size_t)ls * 16 * 3072 + 2048;
    const int lane = threadIdx.x & 63, w = threadIdx.x >> 6, wm = w >> 1, wn = w & 1, r = lane & 31, h = lane >> 5;
    constexpr int MT = 512, NTL = 8;
    for (int tile = blockIdx.x; tile < MT * NTL; tile += gridDim.x) {
        const int mt = tile / NTL, nt = tile % NTL;
        f32x16 acc[2][2]; zero_acc(acc);
        gemm_main<true>(A + (size_t)mt * 128 * K, K, 64, Bt + (size_t)nt * 128 * K, K, K / 64, lds, acc);
        const int b = mt >> 5;
        const float* gb = mod + (size_t)b * 3072;
#pragma unroll
        for (int mi = 0; mi < 2; ++mi) {
            const size_t rowoff = (size_t)(mt * 128 + wm * 64 + mi * 32 + r) * 1024;
#pragma unroll
            for (int ni = 0; ni < 2; ++ni)
#pragma unroll
                for (int a = 0; a < 4; ++a) {
                    const int n = nt * 128 + wn * 64 + ni * 32 + 8 * a + 4 * h;
                    const f32x4 xv = *(const f32x4*)(X + rowoff + n);
                    const f32x4 gv = *(const f32x4*)(gb + n);
                    f32x4 y;
#pragma unroll
                    for (int j = 0; j < 4; ++j) y[j] = ALPHA_RES * xv[j] + (1.f + gv[j]) * acc[mi][ni][4 * a + j];
                    *(f32x4*)(XY + rowoff + n) = y;
                }
        }
    }
}

DI void phase_gemm_ffn_in(const Params& p, char* lds, const u16* Bt) {
    const u16* A = (const u16*)(p.ws + WS_H);
    u16* ACT = (u16*)(p.ws + WS_ACT);
    const int lane = threadIdx.x & 63, w = threadIdx.x >> 6, wm = w >> 1, wn = w & 1, r = lane & 31, h = lane >> 5;
    constexpr int MT = 512, NTL = 44;
    for (int tile = blockIdx.x; tile < MT * NTL; tile += gridDim.x) {
        const int mt = tile / NTL, nt = tile % NTL;
        f32x16 acc[2][2]; zero_acc(acc);
        gemm_main<true>(A + (size_t)mt * 128 * 1024, 1024, 64, Bt + (size_t)nt * 128 * 1024, 1024, 16, lds, acc);
#pragma unroll
        for (int mi = 0; mi < 2; ++mi) {
            u16* rowp = ACT + (size_t)(mt * 128 + wm * 64 + mi * 32 + r) * FF + nt * 64 + wn * 32 + 4 * h;
#pragma unroll
            for (int a = 0; a < 4; ++a) {
                float v[4];
#pragma unroll
                for (int j = 0; j < 4; ++j) v[j] = siluf_(acc[mi][0][4 * a + j]) * acc[mi][1][4 * a + j];
                *(u32x2*)(rowp + 8 * a) = (u32x2){cvtpk(v[0], v[1]), cvtpk(v[2], v[3])};
            }
        }
    }
}

DI void phase_gemm_in1(const Params& p, char* lds) {
    const u16* A = (const u16*)(p.ws + WS_H);
    const u16* Bt = (const u16*)(p.ws + WS_WT_IN1);
    u16* B1 = (u16*)(p.ws + WS_B1);
    u16* CZ = (u16*)(p.ws + WS_CZ);
    const int lane = threadIdx.x & 63, w = threadIdx.x >> 6, wm = w >> 1, wn = w & 1, r = lane & 31, h = lane >> 5;
    constexpr int MT = 512, NTL = 24;
    for (int tile = blockIdx.x; tile < MT * NTL; tile += gridDim.x) {
        const int mt = tile / NTL, nt = tile % NTL;
        f32x16 acc[2][2]; zero_acc(acc);
        gemm_main<true>(A + (size_t)mt * 128 * 1024, 1024, 64, Bt + (size_t)nt * 128 * 1024, 1024, 16, lds, acc);
#pragma unroll
        for (int mi = 0; mi < 2; ++mi) {
            const size_t row = (size_t)(mt * 128 + wm * 64 + mi * 32 + r);
            if (nt < 8) {
                u16* rowp = B1 + row * 1024 + nt * 128 + wn * 64 + 4 * h;
#pragma unroll
                for (int ni = 0; ni < 2; ++ni)
#pragma unroll
                    for (int a = 0; a < 4; ++a)
                        *(u32x2*)(rowp + ni * 32 + 8 * a) = (u32x2){cvtpk(acc[mi][ni][4 * a], acc[mi][ni][4 * a + 1]), cvtpk(acc[mi][ni][4 * a + 2], acc[mi][ni][4 * a + 3])};
            } else {
                u16* rowp = CZ + row * 1024 + (nt - 8) * 64 + wn * 32 + 4 * h;
#pragma unroll
                for (int a = 0; a < 4; ++a) {
                    float v[4];
#pragma unroll
                    for (int j = 0; j < 4; ++j) v[j] = acc[mi][0][4 * a + j] * acc[mi][1][4 * a + j];
                    *(u32x2*)(rowp + 8 * a) = (u32x2){cvtpk(v[0], v[1]), cvtpk(v[2], v[3])};
                }
            }
        }
    }
}

DI void compress_item(const Params& p, int item, char* lds) {
    const int which = item >> 6, g = (item >> 5) & 1, mt = item & 31;
    const int tid = threadIdx.x, lane = tid & 63, w = tid >> 6, wm = w >> 1, wn = w & 1, r = lane & 31, h = lane >> 5;
    const u16* PR = (const u16*)(p.ws + WS_PR);
    const u16* A = PR + (size_t)mt * 128 * 16 * LDP + (which ? 640 : 512) + g * 64;
    const u16* Bt = (const u16*)(p.ws + WS_W1T) + (size_t)which * 128 * 2048;
    f32x16 acc[2][2]; zero_acc(acc);
    gemm_main<true>(A, 16 * LDP, LDP, Bt, 2048, 32, lds, acc);
    const float* b1p = (const float*)(p.ws + WS_B1P) + which * 16 * 128;
#pragma unroll
    for (int ni = 0; ni < 2; ++ni)
#pragma unroll
        for (int a = 0; a < 4; ++a) {
            const int j0 = wn * 64 + ni * 32 + 8 * a + 4 * h;
            float bias[4] = {0.f, 0.f, 0.f, 0.f};
            for (int c = 0; c < 16; ++c) {
                const f32x4 t = *(const f32x4*)(b1p + c * 128 + j0);
                bias[0] += t[0]; bias[1] += t[1]; bias[2] += t[2]; bias[3] += t[3];
            }
#pragma unroll
            for (int mi = 0; mi < 2; ++mi) {
                const int m = wm * 64 + mi * 32 + r;
                float v[4];
#pragma unroll
                for (int j = 0; j < 4; ++j) v[j] = geluf_(acc[mi][ni][4 * a + j] + bias[j]);
                const int chunk = (j0 >> 3) ^ (m & 15);
                *(u32x2*)(lds + m * 256 + chunk * 16 + (j0 & 7) * 2) = (u32x2){cvtpk(v[0], v[1]), cvtpk(v[2], v[3])};
            }
        }
    __syncthreads();
    const u16* W2 = (const u16*)(p.ws + WS_W2T) + which * 64 * 128;
    f32x16 o2[2];
#pragma unroll
    for (int i = 0; i < 16; ++i) { o2[0][i] = 0.f; o2[1][i] = 0.f; }
    const int mrow = 32 * w + r;
#pragma unroll
    for (int ks = 0; ks < 8; ++ks) {
        const bf16x8 hf = *(const bf16x8*)(lds + mrow * 256 + (((ks * 2 + h) ^ (mrow & 15)) << 4));
#pragma unroll
        for (int et = 0; et < 2; ++et) {
            const bf16x8 wf = *(const bf16x8*)(W2 + (et * 32 + r) * 128 + ks * 16 + 8 * h);
            o2[et] = which ? MFMA(hf, wf, o2[et]) : MFMA(wf, hf, o2[et]);
        }
    }
    const int bg_base = (mt >> 1);
    const int nbase = (mt & 1) * 128 + 32 * w;
    if (which == 0) {
        u16* kc = (u16*)(p.ws + WS_KCMP) + ((size_t)(bg_base * 2 + g) * 256 + nbase + r) * 64;
        const bool zero = (nbase + r) == 255;
#pragma unroll
        for (int et = 0; et < 2; ++et)
#pragma unroll
            for (int a = 0; a < 4; ++a) {
                u32x2 v = (u32x2){cvtpk(o2[et][4 * a], o2[et][4 * a + 1]), cvtpk(o2[et][4 * a + 2], o2[et][4 * a + 3])};
                if (zero) v = (u32x2){0u, 0u};
                *(u32x2*)(kc + et * 32 + 8 * a + 4 * h) = v;
            }
    } else {
        u16* vt = (u16*)(p.ws + WS_VCMPT) + (size_t)(bg_base * 2 + g) * 64 * 256;
#pragma unroll
        for (int et = 0; et < 2; ++et)
#pragma unroll
            for (int a = 0; a < 4; ++a) {
                const int n0 = nbase + 8 * a + 4 * h;
                float v3 = o2[et][4 * a + 3];
                if (n0 + 3 == 255) v3 = 0.f;
                *(u32x2*)(vt + (et * 32 + r) * 256 + n0) = (u32x2){cvtpk(o2[et][4 * a], o2[et][4 * a + 1]), cvtpk(o2[et][4 * a + 2], v3)};
            }
    }
    __syncthreads();
}

DI void gmlp_item(const Params& p, int item, char* lds) {
    const int grp = item & 7, chunk = (item >> 3) & 31, b = item >> 8;
    const int tid = threadIdx.x, lane = tid & 63, w = tid >> 6, r = lane & 31, h = lane >> 5;
    const u16* VT = (const u16*)(p.ws + WS_VT) + ((size_t)b * NVT + 256 + grp * 64) * SEQ + chunk * 128;
#pragma unroll
    for (int i = 0; i < 4; ++i) {
        const int id = tid + 256 * i, d = id >> 4, c = id & 15;
        *(u32x4*)(lds + d * 256 + ((c ^ (d & 15)) << 4)) = *(const u32x4*)(VT + (size_t)d * SEQ + c * 8);
    }
    __syncthreads();
    {
        float* red = (float*)(lds + 16384);
        const int s = tid & 127, dh = tid >> 7;
        float v[32]; float sum = 0.f;
#pragma unroll
        for (int i = 0; i < 32; ++i) {
            const int d = dh * 32 + i;
            const u16 raw = *(const u16*)(lds + d * 256 + ((((s >> 3)) ^ (d & 15)) << 4) + (s & 7) * 2);
            v[i] = geluf_(bf2f(raw)); sum += v[i];
        }
        red[dh * 128 + s] = sum;
        __syncthreads();
        const float mu = (red[s] + red[128 + s]) * (1.f / 64.f);
        float sq = 0.f;
#pragma unroll
        for (int i = 0; i < 32; ++i) { const float dlt = v[i] - mu; sq += dlt * dlt; }
        __syncthreads();
        red[dh * 128 + s] = sq;
        __syncthreads();
        const float rstd = rsqrtf((red[s] + red[128 + s]) * (1.f / 64.f) + 1e-5f);
        const float* ng = p.gmlp_norm_g + grp * 64 + dh * 32;
#pragma unroll
        for (int i = 0; i < 32; ++i) {
            const int d = dh * 32 + i;
            const float y = (v[i] - mu) * rstd * ng[i];
            const unsigned pk = cvtpk(y, 0.f);
            *(u16*)(lds + d * 256 + ((((s >> 3)) ^ (d & 15)) << 4) + (s & 7) * 2) = (u16)(pk & 0xffffu);
        }
    }
    __syncthreads();
    const u16* Wt = (const u16*)(p.ws + WS_TRIL) + (size_t)grp * 128 * 128 + (32 * w + r) * 128 + 8 * h;
    f32x16 x[2];
#pragma unroll
    for (int i = 0; i < 16; ++i) { x[0][i] = 0.f; x[1][i] = 0.f; }
    const int nks = 2 * (w + 1);
    for (int ks = 0; ks < nks; ++ks) {
        const bf16x8 wf = *(const bf16x8*)(Wt + ks * 16);
#pragma unroll
        for (int dt = 0; dt < 2; ++dt) {
            const int d = dt * 32 + r;
            const bf16x8 vf = *(const bf16x8*)(lds + d * 256 + (((ks * 2 + h) ^ (d & 15)) << 4));
            x[dt] = MFMA(vf, wf, x[dt]);
        }
    }
    const int t = 32 * w + r;
    const size_t tok = (size_t)b * SEQ + chunk * 128 + t;
    const float bs = p.gmlp_bs[grp * 128 + t];
    const u16* up = (const u16*)(p.ws + WS_PR) + tok * LDP + 1024 + grp * 64 + 4 * h;
    u16* op = (u16*)(p.ws + WS_MIX) + tok * 1024 + 512 + grp * 64 + 4 * h;
#pragma unroll
    for (int dt = 0; dt < 2; ++dt)
#pragma unroll
        for (int a = 0; a < 4; ++a) {
            const u32x2 uu = *(const u32x2*)(up + dt * 32 + 8 * a);
            const float u0 = geluf_(bflo(uu[0])), u1 = geluf_(bfhi(uu[0])), u2 = geluf_(bflo(uu[1])), u3 = geluf_(bfhi(uu[1]));
            *(u32x2*)(op + dt * 32 + 8 * a) = (u32x2){cvtpk(u0 * (x[dt][4 * a] + bs), u1 * (x[dt][4 * a + 1] + bs)), cvtpk(u2 * (x[dt][4 * a + 2] + bs), u3 * (x[dt][4 * a + 3] + bs))};
        }
    __syncthreads();
}

DI f32x16 qk_tile(const u16* __restrict__ Kb, long ldk, int key0, const bf16x8 (&qf)[4], int r, int h) {
    const u16* kp = Kb + (long)(key0 + r) * ldk + 8 * h;
    f32x16 s;
#pragma unroll
    for (int i = 0; i < 16; ++i) s[i] = 0.f;
#pragma unroll
    for (int ks = 0; ks < 4; ++ks) { const bf16x8 kf = *(const bf16x8*)(kp + ks * 16); s = MFMA(kf, qf[ks], s); }
    return s;
}
DI void pv_tile(const u16* __restrict__ Vt, long ldv, int key0, const float (&pr)[16], f32x16 (&o)[2], int r, int h) {
#pragma unroll
    for (int s2 = 0; s2 < 2; ++s2) {
        const u32x4 pk = (u32x4){cvtpk(pr[8 * s2], pr[8 * s2 + 1]), cvtpk(pr[8 * s2 + 2], pr[8 * s2 + 3]), cvtpk(pr[8 * s2 + 4], pr[8 * s2 + 5]), cvtpk(pr[8 * s2 + 6], pr[8 * s2 + 7])};
        const bf16x8 pb = __builtin_bit_cast(bf16x8, pk);
#pragma unroll
        for (int dt = 0; dt < 2; ++dt) {
            const u16* vp = Vt + (long)(dt * 32 + r) * ldv + key0 + 16 * s2 + 4 * h;
            const u32x2 lo = *(const u32x2*)vp, hi = *(const u32x2*)(vp + 8);
            const bf16x8 vf = __builtin_bit_cast(bf16x8, (u32x4){lo[0], lo[1], hi[0], hi[1]});
            o[dt] = MFMA(vf, pb, o[dt]);
        }
    }
}
DI void softmax_step(float (&s)[16], float& m, float& l, f32x16 (&o)[2]) {
    float mx = s[0];
#pragma unroll
    for (int i = 1; i < 16; ++i) mx = fmaxf(mx, s[i]);
    mx = fmaxf(mx, __shfl_xor(mx, 32));
    const float mn = fmaxf(m, mx);
    const float al = fexp2(m - mn);
    float ps = 0.f;
#pragma unroll
    for (int i = 0; i < 16; ++i) { s[i] = fexp2(s[i] - mn); ps += s[i]; }
    l = l * al + ps; m = mn;
#pragma unroll
    for (int i = 0; i < 16; ++i) { o[0][i] *= al; o[1][i] *= al; }
}

DI void nsa_item(const Params& p, int item, char* lds) {
    const int qt = 127 - (item >> 5), bg = item & 31, b = bg >> 1, g = bg & 1;
    const int tid = threadIdx.x, lane = tid & 63, w = tid >> 6, r = lane & 31, h = lane >> 5;
    const int q0 = qt * 32, hq = g * 4 + w, tq = q0 + r;
    const size_t tokb = (size_t)b * SEQ;
    const u16* PR = (const u16*)(p.ws + WS_PR);
    const u16* VT = (const u16*)(p.ws + WS_VT);
    const float SC = 0.125f * 1.4426950408889634f;
    const float NINF = -__builtin_inff();
    bf16x8 qf[4];
    {
        const u16* qp = PR + (tokb + tq) * LDP + hq * 64 + 8 * h;
#pragma unroll
        for (int ks = 0; ks < 4; ++ks) qf[ks] = *(const bf16x8*)(qp + ks * 16);
    }
    float* slab = (float*)lds;
    unsigned long long* masks = (unsigned long long*)(lds + 33280);
    unsigned* uni = (unsigned*)(lds + 33280 + 256);

    f32x16 fin[2];
    {
        const u16* Kc = (const u16*)(p.ws + WS_KCMP) + (size_t)(b * 2 + g) * 256 * 64;
        const u16* VcT = (const u16*)(p.ws + WS_VCMPT) + (size_t)(b * 2 + g) * 64 * 256;
        const int nkb = (q0 >> 9) + 1;
        float m = -1e30f, l = 0.f;
#pragma unroll 1
        for (int kb = 0; kb < nkb; ++kb) {
            const f32x16 sv = qk_tile(Kc, 64, kb * 32, qf, r, h);
            float s[16];
#pragma unroll
            for (int i = 0; i < 16; ++i) { const int n = kb * 32 + crow(i, h); s[i] = (16 * n + 31 <= tq) ? sv[i] * SC : NINF; }
            float mx = s[0];
#pragma unroll
            for (int i = 1; i < 16; ++i) mx = fmaxf(mx, s[i]);
            mx = fmaxf(mx, __shfl_xor(mx, 32));
            const float mn = fmaxf(m, mx);
            float ps = 0.f;
#pragma unroll
            for (int i = 0; i < 16; ++i) ps += fexp2(s[i] - mn);
            l = l * fexp2(m - mn) + ps; m = mn;
        }
        l += __shfl_xor(l, 32);
        const float inv = (l > 0.f) ? 1.f / l : 0.f;
        f32x16 oc[2];
#pragma unroll
        for (int i = 0; i < 16; ++i) { oc[0][i] = 0.f; oc[1][i] = 0.f; }
        float carry = 0.f;
        float* myslab = slab + (w * 32 + r) * 65;
#pragma unroll 1
        for (int kb = 0; kb < 8; ++kb) {
            if (kb < nkb) {
                const f32x16 sv = qk_tile(Kc, 64, kb * 32, qf, r, h);
                float pr[16];
#pragma unroll
                for (int i = 0; i < 16; ++i) { const int n = kb * 32 + crow(i, h); pr[i] = (16 * n + 31 <= tq) ? fexp2(sv[i] * SC - m) * inv : 0.f; }
                float xs[4];
#pragma unroll
                for (int a = 0; a < 4; ++a) xs[a] = __shfl_xor(pr[4 * a + 3], 32);
#pragma unroll
                for (int a = 0; a < 4; ++a) {
                    const float sum = pr[4 * a] + pr[4 * a + 1] + pr[4 * a + 2] + pr[4 * a + 3];
                    const float prev = h ? xs[a] : (a == 0 ? carry : xs[a > 0 ? a - 1 : 0]);
                    myslab[8 * kb + 2 * a + h] = sum + prev;
                }
                carry = xs[3];
                pv_tile(VcT, 256, kb * 32, pr, oc, r, h);
            } else {
#pragma unroll
                for (int a = 0; a < 4; ++a) myslab[8 * kb + 2 * a + h] = 0.f;
            }
        }
        const u16* gp = PR + (tokb + tq) * LDP + 1536 + hq * 3;
        const float g0 = sigmoidf_(bf2f(gp[0]));
#pragma unroll
        for (int i = 0; i < 16; ++i) { fin[0][i] = g0 * oc[0][i]; fin[1][i] = g0 * oc[1][i]; }
    }
    __syncthreads();
    for (int e = tid; e < 2048; e += 256) {
        const int q = e >> 6, j = e & 63;
        const float v = slab[(0 * 32 + q) * 65 + j] + slab[(1 * 32 + q) * 65 + j] + slab[(2 * 32 + q) * 65 + j] + slab[(3 * 32 + q) * 65 + j];
        const int t = q0 + q, cur = t >> 6;
        const bool forced = (j == 0) | (j == cur) | (j == cur - 1);
        const bool valid = (j * 64 <= t);
        slab[q * 65 + j] = forced ? 1e4f : (valid ? v : -1e4f);
    }
    if (tid == 0) { uni[0] = 0u; uni[1] = 0u; }
    __syncthreads();
#pragma unroll 1
    for (int qq = 0; qq < 8; ++qq) {
        const int q = w * 8 + qq;
        const float v = slab[q * 65 + lane];
        int rank = 0;
#pragma unroll 4
        for (int j = 0; j < 64; ++j) { const float u = slab[q * 65 + j]; rank += ((u > v) || (u == v && j < lane)) ? 1 : 0; }
        const unsigned long long mk = __ballot(rank < 16);
        if (lane == 0) { masks[q] = mk; atomicOr(&uni[0], (unsigned)mk); atomicOr(&uni[1], (unsigned)(mk >> 32)); }
    }
    __syncthreads();
    const unsigned long long mymask = masks[r];
    const unsigned long long umask = ((unsigned long long)uni[1] << 32) | uni[0];
    {
        const u16* Ks = PR + tokb * LDP + 768 + g * 64;
        const u16* VsT = VT + ((size_t)b * NVT + 0 + g * 64) * SEQ;
        f32x16 o[2];
#pragma unroll
        for (int i = 0; i < 16; ++i) { o[0][i] = 0.f; o[1][i] = 0.f; }
        float m = -1e30f, l = 0.f;
#pragma unroll 1
        for (int kb = 0; kb <= qt; ++kb) {
            if (!((umask >> (kb >> 1)) & 1ull)) continue;
            const f32x16 sv = qk_tile(Ks, LDP, kb * 32, qf, r, h);
            const bool selb = (mymask >> (kb >> 1)) & 1ull;
            float s[16];
#pragma unroll
            for (int i = 0; i < 16; ++i) { const int key = kb * 32 + crow(i, h); s[i] = (selb && key <= tq) ? sv[i] * SC : NINF; }
            softmax_step(s, m, l, o);
            pv_tile(VsT, SEQ, kb * 32, s, o, r, h);
        }
        l += __shfl_xor(l, 32);
        const u16* gp = PR + (tokb + tq) * LDP + 1536 + hq * 3;
        const float g1 = sigmoidf_(bf2f(gp[1])) * ((l > 0.f) ? 1.f / l : 0.f);
#pragma unroll
        for (int i = 0; i < 16; ++i) { fin[0][i] += g1 * o[0][i]; fin[1][i] += g1 * o[1][i]; }
    }
    {
        const u16* Kw = PR + tokb * LDP + 896 + g * 64;
        const u16* VwT = VT + ((size_t)b * NVT + 128 + g * 64) * SEQ;
        f32x16 o[2];
#pragma unroll
        for (int i = 0; i < 16; ++i) { o[0][i] = 0.f; o[1][i] = 0.f; }
        float m = -1e30f, l = 0.f;
        const int kb0 = (qt - 16 > 0) ? qt - 16 : 0;
#pragma unroll 1
        for (int kb = kb0; kb <= qt; ++kb) {
            const f32x16 sv = qk_tile(Kw, LDP, kb * 32, qf, r, h);
            float s[16];
#pragma unroll
            for (int i = 0; i < 16; ++i) { const int key = kb * 32 + crow(i, h); s[i] = (key <= tq && key + 512 > tq) ? sv[i] * SC : NINF; }
            softmax_step(s, m, l, o);
            pv_tile(VwT, SEQ, kb * 32, s, o, r, h);
        }
        l += __shfl_xor(l, 32);
        const u16* gp = PR + (tokb + tq) * LDP + 1536 + hq * 3;
        const float g2 = sigmoidf_(bf2f(gp[2])) * ((l > 0.f) ? 1.f / l : 0.f);
#pragma unroll
        for (int i = 0; i < 16; ++i) { fin[0][i] += g2 * o[0][i]; fin[1][i] += g2 * o[1][i]; }
    }
    u16* op = (u16*)(p.ws + WS_MIX) + (tokb + tq) * 1024 + hq * 64 + 4 * h;
#pragma unroll
    for (int dt = 0; dt < 2; ++dt)
#pragma unroll
        for (int a = 0; a < 4; ++a)
            *(u32x2*)(op + dt * 32 + 8 * a) = (u32x2){cvtpk(fin[dt][4 * a], fin[dt][4 * a + 1]), cvtpk(fin[dt][4 * a + 2], fin[dt][4 * a + 3])};
}

template <bool LAST>
DI void phase_ln(const Params& p, int k) {
    float* XY = (float*)(p.ws + WS_XY);
    u16* H = (u16*)(p.ws + WS_H);
    const float* lg = p.ln_g + k * 1024; const float* lb = p.ln_b + k * 1024;
    const float* modn = (const float*)(p.ws + WS_MOD) + (size_t)(k + 1) * 16 * 3072;
    const int lane = threadIdx.x & 63, w = threadIdx.x >> 6;
    for (int row = blockIdx.x * 4 + w; row < NT_TOK; row += gridDim.x * 4) {
        const float* xr = XY + (size_t)row * 1024;
        f32x4 v[4]; float sum = 0.f;
#pragma unroll
        for (int i = 0; i < 4; ++i) { v[i] = *(const f32x4*)(xr + i * 256 + lane * 4); sum += v[i][0] + v[i][1] + v[i][2] + v[i][3]; }
        const float mu = wave_sum(sum) * (1.f / 1024.f);
        float sq = 0.f;
#pragma unroll
        for (int i = 0; i < 4; ++i)
#pragma unroll
            for (int j = 0; j < 4; ++j) { const float d = v[i][j] - mu; sq += d * d; }
        const float rstd = rsqrtf(wave_sum(sq) * (1.f / 1024.f) + 1e-5f);
        const int b = row >> 12;
#pragma unroll
        for (int i = 0; i < 4; ++i) {
            const int col = i * 256 + lane * 4;
            const f32x4 gg = *(const f32x4*)(lg + col), bb = *(const f32x4*)(lb + col);
            f32x4 y;
#pragma unroll
            for (int j = 0; j < 4; ++j) y[j] = (v[i][j] - mu) * rstd * gg[j] + bb[j];
            if (LAST) {
                *(f32x4*)(p.out + (size_t)row * 1024 + col) = y;
            } else {
                *(f32x4*)(XY + (size_t)row * 1024 + col) = y;
                const f32x4 sh = *(const f32x4*)(modn + (size_t)b * 3072 + col), sc = *(const f32x4*)(modn + (size_t)b * 3072 + 1024 + col);
                const f32x4 hh = y * (sc + 1.f) + sh;
                *(u32x2*)(H + (size_t)row * 1024 + col) = (u32x2){cvtpk(hh[0], hh[1]), cvtpk(hh[2], hh[3])};
            }
        }
    }
}

DI void phase_conv(const Params& p) {
    const u16* B1 = (const u16*)(p.ws + WS_B1);
    const u16* CZ = (const u16*)(p.ws + WS_CZ);
    u16* G = (u16*)(p.ws + WS_MIX);
    const size_t n8 = (size_t)NT_TOK * 1024 / 8;
    for (size_t e = (size_t)blockIdx.x * 256 + threadIdx.x; e < n8; e += (size_t)gridDim.x * 256) {
        const size_t idx = e * 8; const int col = (int)(idx & 1023); const int t = (int)((idx >> 10) & 4095);
        const u32x4 z0 = *(const u32x4*)(CZ + idx);
        const u32x4 z1 = (t >= 1) ? *(const u32x4*)(CZ + idx - 1024) : (u32x4){0u, 0u, 0u, 0u};
        const u32x4 z2 = (t >= 2) ? *(const u32x4*)(CZ + idx - 2048) : (u32x4){0u, 0u, 0u, 0u};
        const u32x4 bb = *(const u32x4*)(B1 + idx);
        const float* cw = p.odd_conv_w + col;
        float o[8];
#pragma unroll
        for (int j = 0; j < 4; ++j) {
            const int c0 = 2 * j, c1 = 2 * j + 1;
            const float y0 = bflo(z2[j]) * cw[c0] + bflo(z1[j]) * cw[1024 + c0] + bflo(z0[j]) * cw[2048 + c0];
            const float y1 = bfhi(z2[j]) * cw[c1] + bfhi(z1[j]) * cw[1024 + c1] + bfhi(z0[j]) * cw[2048 + c1];
            o[c0] = bflo(bb[j]) * y0; o[c1] = bfhi(bb[j]) * y1;
        }
        *(u32x4*)(G + idx) = (u32x4){cvtpk(o[0], o[1]), cvtpk(o[2], o[3]), cvtpk(o[4], o[5]), cvtpk(o[6], o[7])};
    }
}

__global__ void __launch_bounds__(256, 2) fwd_megakernel(Params p) {
    __shared__ __attribute__((aligned(16))) char lds[65536];
    cg::grid_group grid = cg::this_grid();
    unsigned char* ws = p.ws;
    phase0(p, lds);
    grid.sync();
    phase_mod_x(p);
    grid.sync();
    phase_gemm_in0(p, lds);
    grid.sync();
    for (int it = blockIdx.x; it < 128 + 4096; it += gridDim.x) {
        if (it < 128) compress_item(p, it, lds); else gmlp_item(p, it - 128, lds);
    }
    grid.sync();
    for (int it = blockIdx.x; it < 4096; it += gridDim.x) { nsa_item(p, it, lds); __syncthreads(); }
    grid.sync();
    phase_gemm_res(p, lds, (const u16*)(ws + WS_MIX), 1024, (const u16*)(ws + WS_WT_OUT0), p.x, 0);
    grid.sync();
    phase_ln<false>(p, 0);
    grid.sync();
    phase_gemm_ffn_in(p, lds, (const u16*)(ws + WS_WT_FI0));
    grid.sync();
    phase_gemm_res(p, lds, (const u16*)(ws + WS_ACT), FF, (const u16*)(ws + WS_WT_FO0), (const float*)(ws + WS_XY), 1);
    grid.sync();
    phase_ln<false>(p, 1);
    grid.sync();
    phase_gemm_in1(p, lds);
    grid.sync();
    phase_conv(p);
    grid.sync();
    phase_gemm_res(p, lds, (const u16*)(ws + WS_MIX), 1024, (const u16*)(ws + WS_WT_OUT1), (const float*)(ws + WS_XY), 2);
    grid.sync();
    phase_ln<false>(p, 2);
    grid.sync();
    phase_gemm_ffn_in(p, lds, (const u16*)(ws + WS_WT_FI1));
    grid.sync();
    phase_gemm_res(p, lds, (const u16*)(ws + WS_ACT), FF, (const u16*)(ws + WS_WT_FO1), (const float*)(ws + WS_XY), 3);
    grid.sync();
    phase_ln<true>(p, 3);
}

extern "C" void kernel_launch(void* const* d_in, const int* in_sizes, int n_in, void* d_out, int out_size, void* d_ws, size_t ws_size,
                              hipStream_t stream) {
    static int grid_blocks = 0;
    if (!grid_blocks) {
        int dev = 0, cus = 0, per_cu = 0;
        hipGetDevice(&dev);
        hipDeviceGetAttribute(&cus, hipDeviceAttributeMultiprocessorCount, dev);
        hipOccupancyMaxActiveBlocksPerMultiprocessor(&per_cu, fwd_megakernel, 256, 0);
        if (per_cu < 1) per_cu = 1;
        if (per_cu > 2) per_cu = 2;
        grid_blocks = cus * per_cu;
        if (ws_size < WS_END) fprintf(stderr, "kernel_launch: workspace too small: %zu < %zu\n", ws_size, (size_t)WS_END);
    }
    Params p{};
    p.x = (const float*)d_in[0]; p.c = (const float*)d_in[1]; p.ada_w = (const float*)d_in[2]; p.ada_b = (const float*)d_in[3];
    p.ln_g = (const float*)d_in[4]; p.ln_b = (const float*)d_in[5]; p.even_w_in = (const float*)d_in[6]; p.cmp_pos = (const float*)d_in[7];
    p.cmp_w1 = (const float*)d_in[8]; p.cmp_w2 = (const float*)d_in[9]; p.gmlp_norm_g = (const float*)d_in[10]; p.gmlp_ws = (const float*)d_in[11];
    p.gmlp_bs = (const float*)d_in[12]; p.even_w_out = (const float*)d_in[13]; p.odd_w_in = (const float*)d_in[14]; p.odd_conv_w = (const float*)d_in[15];
    p.odd_w_out = (const float*)d_in[16]; p.ffn_w_in = (const float*)d_in[17]; p.ffn_w_out = (const float*)d_in[18];
    p.out = (float*)d_out; p.ws = (unsigned char*)d_ws;
    void* args[] = {&p};
    hipError_t e = hipLaunchCooperativeKernel((void*)fwd_megakernel, dim3(grid_blocks), dim3(256), args, 0, stream);
    if (e != hipSuccess) fprintf(stderr, "cooperative launch failed: %s (grid %d)\n", hipGetErrorString(e), grid_blocks);
}
```

```cpp
#include <hip/hip_runtime.h>
#include <hip/hip_cooperative_groups.h>
#include <cstdio>
namespace cg = cooperative_groups;

#define DI __device__ __forceinline__
#define TIDX (threadIdx.x & 255)
#define VBLK ((int)(blockIdx.x * 2) + __builtin_amdgcn_readfirstlane((int)(threadIdx.x >> 8)))
#define VGRD (gridDim.x * 2)
typedef unsigned short u16;
typedef short bf16x8 __attribute__((ext_vector_type(8)));
typedef float f32x16 __attribute__((ext_vector_type(16)));
typedef float f32x4 __attribute__((ext_vector_type(4)));
typedef float f32x2_t __attribute__((ext_vector_type(2)));
typedef __bf16 bf16x2_t __attribute__((ext_vector_type(2)));
typedef unsigned u32x4 __attribute__((ext_vector_type(4)));
typedef unsigned u32x2 __attribute__((ext_vector_type(2)));
#define MFMA(a, b, c) __builtin_amdgcn_mfma_f32_32x32x16_bf16((a), (b), (c), 0, 0, 0)

constexpr int NT_TOK = 65536;
constexpr int SEQ = 4096;
constexpr int DM = 1024;
constexpr int FF = 2816;
constexpr int LDP = 1792;
constexpr int NVT = 768;
constexpr float ALPHA_RES = 1.4142135623730951f;

constexpr size_t AL(size_t x) { return (x + 255) & ~(size_t)255; }
constexpr size_t WS_WT_IN0 = 0;
constexpr size_t WS_WT_OUT0 = WS_WT_IN0 + AL((size_t)2560 * 1024 * 2);
constexpr size_t WS_WT_FI0 = WS_WT_OUT0 + AL((size_t)1024 * 1024 * 2);
constexpr size_t WS_WT_FI1 = WS_WT_FI0 + AL((size_t)5632 * 1024 * 2);
constexpr size_t WS_WT_FO0 = WS_WT_FI1 + AL((size_t)5632 * 1024 * 2);
constexpr size_t WS_WT_FO1 = WS_WT_FO0 + AL((size_t)1024 * 2816 * 2);
constexpr size_t WS_WT_IN1 = WS_WT_FO1 + AL((size_t)1024 * 2816 * 2);
constexpr size_t WS_WT_OUT1 = WS_WT_IN1 + AL((size_t)3072 * 1024 * 2);
constexpr size_t WS_W1T = WS_WT_OUT1 + AL((size_t)1024 * 1024 * 2);
constexpr size_t WS_W2T = WS_W1T + AL((size_t)2 * 128 * 2048 * 2);
constexpr size_t WS_TRIL = WS_W2T + AL((size_t)2 * 64 * 128 * 2);
constexpr size_t WS_MOD = WS_TRIL + AL((size_t)8 * 128 * 128 * 2);
constexpr size_t WS_B1P = WS_MOD + AL((size_t)4 * 16 * 3072 * 4);
constexpr size_t WS_KCMP = WS_B1P + AL((size_t)2 * 16 * 128 * 4);
constexpr size_t WS_VCMPT = WS_KCMP + AL((size_t)32 * 256 * 64 * 2);
constexpr size_t WS_XY = WS_VCMPT + AL((size_t)32 * 64 * 256 * 2);
constexpr size_t WS_STATS = WS_XY + AL((size_t)NT_TOK * 1024 * 2);
constexpr size_t WS_H = WS_XY + AL((size_t)NT_TOK * 1024 * 4);
constexpr size_t WS_MIX = WS_H + AL((size_t)NT_TOK * 1024 * 2);
constexpr size_t WS_P = WS_MIX + AL((size_t)NT_TOK * 1024 * 2);
constexpr size_t WS_PR = WS_P;
constexpr size_t WS_VT = WS_PR + AL((size_t)(NT_TOK + 16) * LDP * 2);
constexpr size_t WS_ACT = WS_P;
constexpr size_t WS_B1 = WS_P;
constexpr size_t WS_CZ = WS_B1 + AL((size_t)NT_TOK * 1024 * 2);
constexpr size_t WS_PEND = WS_P + AL((size_t)NT_TOK * 2816 * 2);
constexpr size_t FRAG_BYTES = (size_t)32 * 128 * 4 * 64 * 8 * 2;
constexpr size_t WS_KSF = WS_PEND;
constexpr size_t WS_KWF = WS_KSF + FRAG_BYTES;
constexpr size_t WS_VSF = WS_KWF + FRAG_BYTES;
constexpr size_t WS_VWF = WS_VSF + FRAG_BYTES;
constexpr size_t WS_BAR = WS_VWF + FRAG_BYTES;
constexpr size_t WS_END = WS_BAR + 16384;

struct Params {
    const float* x; const float* c; const float* ada_w; const float* ada_b; const float* ln_g; const float* ln_b;
    const float* even_w_in; const float* cmp_pos; const float* cmp_w1; const float* cmp_w2;
    const float* gmlp_norm_g; const float* gmlp_ws; const float* gmlp_bs; const float* even_w_out;
    const float* odd_w_in; const float* odd_conv_w; const float* odd_w_out; const float* ffn_w_in; const float* ffn_w_out;
    float* out; unsigned char* ws;
};

DI unsigned cvtpk(float lo, float hi) { f32x2_t v = {lo, hi}; bf16x2_t b = __builtin_convertvector(v, bf16x2_t); return __builtin_bit_cast(unsigned, b); }
DI float bf2f(u16 v) { return __uint_as_float(((unsigned)v) << 16); }
DI float bflo(unsigned v) { return __uint_as_float(v << 16); }
DI float bfhi(unsigned v) { return __uint_as_float(v & 0xffff0000u); }
DI int crow(int i, int h) { return (i & 3) + 8 * (i >> 2) + 4 * h; }
DI float fexp2(float x) { return __builtin_amdgcn_exp2f(x); }
DI float sigmoidf_(float x) { return __builtin_amdgcn_rcpf(1.f + fexp2(-1.4426950408889634f * x)); }
DI float siluf_(float x) { return x * __builtin_amdgcn_rcpf(1.f + fexp2(-1.4426950408889634f * x)); }
DI float geluf_(float x) {
    const float u = 1.5957691216057308f * (x + 0.044715f * x * x * x);
    return x * __builtin_amdgcn_rcpf(1.f + fexp2(-1.4426950408889634f * u));
}
DI float wave_sum(float v) {
#pragma unroll
    for (int o = 32; o >= 1; o >>= 1) v += __shfl_xor(v, o);
    return v;
}

template <bool TR>
DI void gemm_main(const u16* __restrict__ A, long lda, long akc, const u16* __restrict__ Bt, long ldb, int nk,
                  char* lds, f32x16 (&acc)[2][2]) {
    const int tid = TIDX, lane = tid & 63, w = tid >> 6, wm = w >> 1, wn = w & 1, r = lane & 31, h = lane >> 5;
    const int lrow = tid >> 3, lc = tid & 7;
    const int soff = lrow * 128 + ((lc ^ ((lrow >> 1) & 7)) << 4);
    const u16* ag = A + (long)lrow * lda + lc * 8;
    const u16* bg = Bt + (long)lrow * ldb + lc * 8;
    u32x4 ra[4], rb[4];
#pragma unroll
    for (int i = 0; i < 4; ++i) {
        ra[i] = *(const u32x4*)(ag + (long)(32 * i) * lda);
        rb[i] = *(const u32x4*)(bg + (long)(32 * i) * ldb);
    }
#pragma unroll
    for (int i = 0; i < 4; ++i) {
        *(u32x4*)(lds + soff + i * 4096) = ra[i];
        *(u32x4*)(lds + 16384 + soff + i * 4096) = rb[i];
    }
    __syncthreads();
    const int sw = (r >> 1) & 7;
    const int arow = (wm * 64 + r) * 128, brow = (wn * 64 + r) * 128;
    for (int kt = 0; kt < nk; ++kt) {
        char* cur = lds + (kt & 1) * 32768;
        char* nxt = lds + ((kt + 1) & 1) * 32768;
        const bool more = (kt + 1 < nk);
        if (more) {
            const u16* ag2 = ag + (long)(kt + 1) * akc;
            const u16* bg2 = bg + (long)(kt + 1) * 64;
#pragma unroll
            for (int i = 0; i < 4; ++i) {
                ra[i] = *(const u32x4*)(ag2 + (long)(32 * i) * lda);
                rb[i] = *(const u32x4*)(bg2 + (long)(32 * i) * ldb);
            }
        }
#pragma unroll
        for (int ks = 0; ks < 4; ++ks) {
            const int co = ((ks * 2 + h) ^ sw) << 4;
            bf16x8 af[2], bfr[2];
#pragma unroll
            for (int i = 0; i < 2; ++i) {
                af[i] = *(const bf16x8*)(cur + arow + i * 4096 + co);
                bfr[i] = *(const bf16x8*)(cur + 16384 + brow + i * 4096 + co);
            }
#pragma unroll
            for (int mi = 0; mi < 2; ++mi)
#pragma unroll
                for (int ni = 0; ni < 2; ++ni)
                    acc[mi][ni] = TR ? MFMA(bfr[ni], af[mi], acc[mi][ni]) : MFMA(af[mi], bfr[ni], acc[mi][ni]);
        }
        if (more) {
#pragma unroll
            for (int i = 0; i < 4; ++i) {
                *(u32x4*)(nxt + soff + i * 4096) = ra[i];
                *(u32x4*)(nxt + 16384 + soff + i * 4096) = rb[i];
            }
        }
        __syncthreads();
    }
}

template <bool TR>
DI void gemm_main_pf2(const u16* __restrict__ A, long lda, long akc, const u16* __restrict__ Bt, long ldb, int nk,
                      char* lds, f32x16 (&acc)[2][2]) {
    const int tid = TIDX, lane = tid & 63, w = tid >> 6, wm = w >> 1, wn = w & 1, r = lane & 31, h = lane >> 5;
    const int lrow = tid >> 3, lc = tid & 7;
    const int soff = lrow * 128 + ((lc ^ ((lrow >> 1) & 7)) << 4);
    const u16* ag = A + (long)lrow * lda + lc * 8;
    const u16* bg = Bt + (long)lrow * ldb + lc * 8;
    u32x4 ra0[4], rb0[4], ra1[4], rb1[4];
    auto gload = [&](u32x4 (&ra)[4], u32x4 (&rb)[4], int kt) {
        const u16* ag2 = ag + (long)kt * akc; const u16* bg2 = bg + (long)kt * 64;
#pragma unroll
        for (int i = 0; i < 4; ++i) { ra[i] = *(const u32x4*)(ag2 + (long)(32 * i) * lda); rb[i] = *(const u32x4*)(bg2 + (long)(32 * i) * ldb); }
    };
    auto lstore = [&](const u32x4 (&ra)[4], const u32x4 (&rb)[4], char* buf) {
#pragma unroll
        for (int i = 0; i < 4; ++i) { *(u32x4*)(buf + soff + i * 4096) = ra[i]; *(u32x4*)(buf + 16384 + soff + i * 4096) = rb[i]; }
    };
    const int sw = (r >> 1) & 7;
    const int arow = (wm * 64 + r) * 128, brow = (wn * 64 + r) * 128;
    auto compute = [&](const char* cur) {
#pragma unroll
        for (int ks = 0; ks < 4; ++ks) {
            const int co = ((ks * 2 + h) ^ sw) << 4;
            bf16x8 af[2], bfr[2];
#pragma unroll
            for (int i = 0; i < 2; ++i) { af[i] = *(const bf16x8*)(cur + arow + i * 4096 + co); bfr[i] = *(const bf16x8*)(cur + 16384 + brow + i * 4096 + co); }
#pragma unroll
            for (int mi = 0; mi < 2; ++mi)
#pragma unroll
                for (int ni = 0; ni < 2; ++ni)
                    acc[mi][ni] = TR ? MFMA(bfr[ni], af[mi], acc[mi][ni]) : MFMA(af[mi], bfr[ni], acc[mi][ni]);
        }
    };
    gload(ra0, rb0, 0);
    gload(ra1, rb1, 1);
    lstore(ra0, rb0, lds);
    __syncthreads();
#pragma unroll 1
    for (int kt = 0; kt < nk; kt += 2) {
        gload(ra0, rb0, kt + 2 < nk ? kt + 2 : nk - 1);
        compute(lds);
        lstore(ra1, rb1, lds + 32768);
        __syncthreads();
        gload(ra1, rb1, kt + 3 < nk ? kt + 3 : nk - 1);
        compute(lds + 32768);
        lstore(ra0, rb0, lds);
        __syncthreads();
    }
}

DI void zero_acc(f32x16 (&acc)[2][2]) {
#pragma unroll
    for (int a = 0; a < 2; ++a)
#pragma unroll
        for (int b = 0; b < 2; ++b)
#pragma unroll
            for (int i = 0; i < 16; ++i) acc[a][b][i] = 0.f;
}

DI int src_col(int kind, int p) {
    if (kind == 0) return p;
    if (kind == 1) {
        if (p < 896) return p;
        if (p < 1024) return p + 128;
        if (p < 1536) return p - 1024 + 1304;
        if (p < 1560) return p - 1536 + 1280;
        if (p < 1792) return -1;
        if (p < 1920) return p - 1792 + 896;
        if (p < 2048) return p - 1920 + 1152;
        return p - 2048 + 1816;
    }
    if (kind == 2) {
        const int tile = p >> 8, bj = (p >> 7) & 1, i = p & 127;
        return (bj ? FF : 0) + tile * 128 + i;
    }
    if (p < 1024) return p;
    const int pp = p - 1024, tile = pp >> 8, bj = (pp >> 7) & 1, i = pp & 127;
    return 1024 + (bj ? 1024 : 0) + tile * 128 + i;
}

struct TrJob { const float* src; u16* dst; int K, ldn, kind, pt, ktile; };
DI void tr_load(const TrJob& j, float (&v)[16], int tid) {
    const int nl = tid & 63, kq = tid >> 6;
    const int sc = src_col(j.kind, j.pt * 64 + nl);
    const float* sp = j.src + (long)(j.ktile * 64 + kq) * j.ldn + (sc >= 0 ? sc : 0);
    float scl = 1.f;
    if (j.kind == 2) scl = (((j.pt * 64 + nl) >> 7) & 1) ? -0.6931471805599453f : -1.4426950408889634f;
#pragma unroll
    for (int i = 0; i < 16; ++i) v[i] = (sc >= 0) ? sp[(long)(4 * i) * j.ldn] * scl : 0.f;
}
DI void tr_to_lds(const float (&v)[16], char* lds, int tid) {
    float* tile = (float*)lds;
    const int nl = tid & 63, kq = tid >> 6;
#pragma unroll
    for (int i = 0; i < 16; ++i) tile[(kq + 4 * i) * 65 + nl] = v[i];
}
DI void tr_store(const TrJob& j, char* lds, int tid) {
    const float* tile = (const float*)lds;
    const int n = tid >> 2, part = tid & 3;
    unsigned pk[8];
#pragma unroll
    for (int q = 0; q < 8; ++q) pk[q] = cvtpk(tile[(part * 16 + 2 * q) * 65 + n], tile[(part * 16 + 2 * q + 1) * 65 + n]);
    u16* dp = j.dst + (long)(j.pt * 64 + n) * j.K + j.ktile * 64 + part * 16;
    *(u32x4*)dp = (u32x4){pk[0], pk[1], pk[2], pk[3]};
    *(u32x4*)(dp + 8) = (u32x4){pk[4], pk[5], pk[6], pk[7]};
}

template <int PART>
DI void phase0(const Params& p, char* lds) {
    const int tid = TIDX;
    unsigned char* ws = p.ws;
    constexpr int N_ADA = 384, N_B1 = 32, N_TRIL = 64;
    constexpr int NJ = 12;
    const int jitems[NJ] = {40 * 16, 16 * 16, 88 * 16, 88 * 16, 16 * 44, 16 * 44, 48 * 16, 16 * 16, 2 * 32, 2 * 32, 1 * 2, 1 * 2};
    int total = N_ADA + N_B1 + N_TRIL;
#pragma unroll
    for (int j = 0; j < NJ; ++j) total += jitems[j];
    for (int it = VBLK; PART == 0 && it < N_ADA + N_B1 + N_TRIL; it += VGRD) {
        if (it < N_ADA) {
            const int ls = it / 96, cgp = it % 96;
            float* sc = (float*)lds;
#pragma unroll 16
            for (int e = tid; e < 16384; e += 256) { const int k = e >> 4, b = e & 15; sc[e] = siluf_(p.c[b * 1024 + k]); }
            __syncthreads();
            const int cq = tid & 7, kg = tid >> 3;
            const float* W = p.ada_w + (size_t)ls * 1024 * 3072 + cgp * 32 + cq * 4;
            f32x4 acc[16];
#pragma unroll
            for (int b = 0; b < 16; ++b) acc[b] = (f32x4){0.f, 0.f, 0.f, 0.f};
#pragma unroll 8
            for (int ki = 0; ki < 32; ++ki) {
                const int k = ki * 32 + kg;
                const f32x4 wv = *(const f32x4*)(W + (size_t)k * 3072);
                const f32x4* s4 = (const f32x4*)(sc + k * 16);
#pragma unroll
                for (int q = 0; q < 4; ++q) { const f32x4 sv = s4[q]; acc[4 * q] += wv * sv[0]; acc[4 * q + 1] += wv * sv[1]; acc[4 * q + 2] += wv * sv[2]; acc[4 * q + 3] += wv * sv[3]; }
            }
            __syncthreads();
            float* red = (float*)lds;
#pragma unroll
            for (int b = 0; b < 16; ++b) *(f32x4*)(red + (kg * 16 + b) * 32 + cq * 4) = acc[b];
            __syncthreads();
            float* mod = (float*)(ws + WS_MOD);
            for (int e = tid; e < 512; e += 256) {
                const int b = e >> 5, cl = e & 31;
                float v = 0.f;
#pragma unroll 8
                for (int g2 = 0; g2 < 32; ++g2) v += red[(g2 * 16 + b) * 32 + cl];
                mod[((size_t)ls * 16 + b) * 3072 + cgp * 32 + cl] = v + p.ada_b[ls * 3072 + cgp * 32 + cl];
            }
            __syncthreads();
            continue;
        }
        int i2 = it - N_ADA;
        if (i2 < N_B1) {
            const int wh = i2 >> 4, ch = i2 & 15;
            const int col = tid & 127, half = tid >> 7;
            const float* pos = p.cmp_pos + wh * 2048 + ch * 128 + half * 64;
            const float* w1 = p.cmp_w1 + ((size_t)wh * 2048 + ch * 128 + half * 64) * 128 + col;
            float a = 0.f;
#pragma unroll 8
            for (int k = 0; k < 64; ++k) a += pos[k] * w1[(size_t)k * 128];
            float* red = (float*)lds;
            red[tid] = a;
            __syncthreads();
            if (tid < 128) ((float*)(ws + WS_B1P))[(wh * 16 + ch) * 128 + tid] = red[tid] + red[tid + 128];
            __syncthreads();
            continue;
        }
        i2 -= N_B1;
        if (i2 < N_TRIL) {
            u16* dst = (u16*)(ws + WS_TRIL);
            const int e0 = (i2 * 256 + tid) * 8;
            const int s0 = e0 & 127, t = (e0 >> 7) & 127;
            const f32x4 a = *(const f32x4*)(p.gmlp_ws + e0), b = *(const f32x4*)(p.gmlp_ws + e0 + 4);
            float v[8] = {a[0], a[1], a[2], a[3], b[0], b[1], b[2], b[3]};
#pragma unroll
            for (int j = 0; j < 8; ++j) if (s0 + j > t) v[j] = 0.f;
            *(u32x4*)(dst + e0) = (u32x4){cvtpk(v[0], v[1]), cvtpk(v[2], v[3]), cvtpk(v[4], v[5]), cvtpk(v[6], v[7])};
            continue;
        }
    }
    auto decode = [&](int i2) {
        int job = 0;
#pragma unroll
        for (int j = 0; j < NJ; ++j) { if (job == j && i2 >= jitems[j]) { i2 -= jitems[j]; job = j + 1; } }
        const float* src; u16* dst; int K, ldn, kind;
        switch (job) {
            case 0: src = p.even_w_in; dst = (u16*)(ws + WS_WT_IN0); K = 1024; ldn = 2328; kind = 1; break;
            case 1: src = p.even_w_out; dst = (u16*)(ws + WS_WT_OUT0); K = 1024; ldn = 1024; kind = 0; break;
            case 2: src = p.ffn_w_in; dst = (u16*)(ws + WS_WT_FI0); K = 1024; ldn = 5632; kind = 2; break;
            case 3: src = p.ffn_w_in + (size_t)1024 * 5632; dst = (u16*)(ws + WS_WT_FI1); K = 1024; ldn = 5632; kind = 2; break;
            case 4: src = p.ffn_w_out; dst = (u16*)(ws + WS_WT_FO0); K = 2816; ldn = 1024; kind = 0; break;
            case 5: src = p.ffn_w_out + (size_t)2816 * 1024; dst = (u16*)(ws + WS_WT_FO1); K = 2816; ldn = 1024; kind = 0; break;
            case 6: src = p.odd_w_in; dst = (u16*)(ws + WS_WT_IN1); K = 1024; ldn = 3072; kind = 3; break;
            case 7: src = p.odd_w_out; dst = (u16*)(ws + WS_WT_OUT1); K = 1024; ldn = 1024; kind = 0; break;
            case 8: src = p.cmp_w1; dst = (u16*)(ws + WS_W1T); K = 2048; ldn = 128; kind = 0; break;
            case 9: src = p.cmp_w1 + (size_t)2048 * 128; dst = (u16*)(ws + WS_W1T) + (size_t)128 * 2048; K = 2048; ldn = 128; kind = 0; break;
            case 10: src = p.cmp_w2; dst = (u16*)(ws + WS_W2T); K = 128; ldn = 64; kind = 0; break;
            default: src = p.cmp_w2 + 128 * 64; dst = (u16*)(ws + WS_W2T) + 64 * 128; K = 128; ldn = 64; kind = 0; break;
        }
        const int nkt = K / 64, npt = jitems[job] / nkt;
        return TrJob{src, dst, K, ldn, kind, i2 % npt, i2 / npt};
    };
    const int ntr_all = total - (N_ADA + N_B1 + N_TRIL);
    constexpr int NPRE = N_ADA + N_B1 + N_TRIL, NA = (512 - NPRE) * 2;
    int it, ntr, tstride;
    if (PART == 0) { it = VBLK - NPRE; if (it < 0) it = NA; ntr = NA; tstride = VGRD - NPRE; }
    else { it = NA + VBLK; ntr = ntr_all; tstride = VGRD; }
    float v[16];
    TrJob cur{};
    if (it < ntr) { cur = decode(it); tr_load(cur, v, tid); }
    while (it < ntr) {
        tr_to_lds(v, lds, tid);
        __syncthreads();
        const int nit = it + tstride;
        TrJob nxt{};
        nxt = decode(nit < ntr ? nit : it); tr_load(nxt, v, tid);
        tr_store(cur, lds, tid);
        __syncthreads();
        cur = nxt; it = nit;
    }
}

DI void phase_mod_x(const Params& p) {
    const float* mod = (const float*)(p.ws + WS_MOD);
    u16* H = (u16*)(p.ws + WS_H);
    const size_t n8 = (size_t)NT_TOK * 1024 / 8;
    const size_t stride = (size_t)VGRD * 256;
    size_t e = (size_t)VBLK * 256 + TIDX;
    for (; e + 3 * stride < n8; e += 4 * stride) {
        f32x4 x0[4], x1[4];
#pragma unroll
        for (int k = 0; k < 4; ++k) { const size_t idx = (e + k * stride) * 8; x0[k] = *(const f32x4*)(p.x + idx); x1[k] = *(const f32x4*)(p.x + idx + 4); }
        f32x4 sh0[4], sh1[4], sc0[4], sc1[4];
#pragma unroll
        for (int k = 0; k < 4; ++k) {
            const size_t idx = (e + k * stride) * 8; const int col = (int)(idx & 1023); const int b = (int)(idx >> 22);
            const float* mb = mod + (size_t)b * 3072;
            sh0[k] = *(const f32x4*)(mb + col); sh1[k] = *(const f32x4*)(mb + col + 4);
            sc0[k] = *(const f32x4*)(mb + 1024 + col); sc1[k] = *(const f32x4*)(mb + 1024 + col + 4);
        }
#pragma unroll
        for (int k = 0; k < 4; ++k) {
            const size_t idx = (e + k * stride) * 8;
            const f32x4 h0 = x0[k] * (sc0[k] + 1.f) + sh0[k], h1 = x1[k] * (sc1[k] + 1.f) + sh1[k];
            *(u32x4*)(H + idx) = (u32x4){cvtpk(h0[0], h0[1]), cvtpk(h0[2], h0[3]), cvtpk(h1[0], h1[1]), cvtpk(h1[2], h1[3])};
        }
    }
    for (; e < n8; e += stride) {
        const size_t idx = e * 8; const int col = (int)(idx & 1023); const int b = (int)(idx >> 22);
        const float* mb = mod + (size_t)b * 3072;
        const f32x4 x0 = *(const f32x4*)(p.x + idx), x1 = *(const f32x4*)(p.x + idx + 4);
        const f32x4 sh0 = *(const f32x4*)(mb + col), sh1 = *(const f32x4*)(mb + col + 4);
        const f32x4 sc0 = *(const f32x4*)(mb + 1024 + col), sc1 = *(const f32x4*)(mb + 1024 + col + 4);
        const f32x4 h0 = x0 * (sc0 + 1.f) + sh0, h1 = x1 * (sc1 + 1.f) + sh1;
        *(u32x4*)(H + idx) = (u32x4){cvtpk(h0[0], h0[1]), cvtpk(h0[2], h0[3]), cvtpk(h1[0], h1[1]), cvtpk(h1[2], h1[3])};
    }
}

namespace pg8 {
#define PG8_LAS __attribute__((address_space(3)))
typedef unsigned short bf16_t;
typedef short bf16x8 __attribute__((ext_vector_type(8)));
typedef float f32x4 __attribute__((ext_vector_type(4)));
typedef unsigned u32x4 __attribute__((ext_vector_type(4)));
constexpr int BM = 256, BK = 64, HALF = 128, HTB = HALF * BK * 2  , STAGE_BYTES = 8 * HTB, NXCD = 8, WGM = 8;

__host__ __device__ __forceinline__ int lds_byte(int r, int c) { const int st = (r >> 4) * 2 + (c >> 5), rr = r & 15, cc = c & 31, ob = rr * 64 + cc * 2; return st * 1024 + (ob ^ (((ob >> 9) & 1) << 5)); }
__host__ __device__ __forceinline__ void stage_rc(int b, int& R, int& C) { const int st = b / 1024, sb = b % 1024, swz = sb ^ (((sb >> 9) & 1) << 5); R = (st >> 1) * 16 + swz / 64; C = (st & 1) * 32 + (swz % 64) / 2; }
__host__ __device__ __forceinline__ int perm32(int rho) { const int n = rho >> 4, i = rho & 15; return 8 * (i >> 2) + 4 * n + (i & 3); }

struct Unit { int pm, pn; };
struct Gemm { const bf16_t* A; const bf16_t* Bt; int M, N, K; };

struct StaticOrder {
    int nM, nN, nwg, G, c;
    __host__ __device__ void init(int M, int N, int G_, int c_) { nM = M / BM; nN = N / BM; nwg = nM * nN; G = G_; c = c_; }
    __host__ __device__ bool next(int i, Unit& u) const {
        const long L = (long)i * G + c; if (L >= nwg) return false;
        int wgid = (int)L; { const int q = nwg / NXCD, r = nwg % NXCD, xcd = wgid % NXCD, off = wgid / NXCD; wgid = (xcd < r ? xcd * (q + 1) : r * (q + 1) + (xcd - r) * q) + off; }
        const int nig = WGM * nN, gid = wgid / nig, fm = gid * WGM, gsz = (nM - fm) < WGM ? (nM - fm) : WGM;
        u.pm = fm + ((wgid % nig) % gsz); u.pn = (wgid % nig) / gsz; return true;
    }
    __device__ __forceinline__ void a_ready(const Unit&) const {}
    __device__ __forceinline__ void done(const Unit&) const {}
};
template <class Epi, class Sched, bool STAMP = false>
__device__ __forceinline__ void gemm_phase(PG8_LAS unsigned char* lds, const Gemm g, const Sched& S, const Epi& E, unsigned long long* stamps) {
    int tid = threadIdx.x;
    asm volatile("" : "+v"(tid));
    const int wid = __builtin_amdgcn_readfirstlane(tid >> 6), lane = tid & 63, wr = wid >> 2, wc = wid & 3, fr = lane & 15, fq = lane >> 4;
    const int K = g.K, nt = K / BK;
    int ts_lo = 0, ts_hi = 0, nts = 0; const unsigned long long rt_entry = STAMP ? (unsigned long long)wall_clock64() : 0ull;
#define PG8_STAMP() do { if (STAMP && wid == 0 && nts < 64) { const unsigned long long _c = (unsigned long long)clock64(); \
        ts_lo = (lane == nts) ? (int)(unsigned)_c : ts_lo; ts_hi = (lane == nts) ? (int)(unsigned)(_c >> 32) : ts_hi; ++nts; } } while (0)
    PG8_STAMP();
    unsigned voffA[2], voffB[2];
#pragma unroll
    for (int i = 0; i < 2; ++i) { int R, C; stage_rc(tid * 16 + i * 8192, R, C); const int Rb = Epi::PERM ? ((R & ~31) + perm32(R & 31)) : R;
        voffA[i] = (unsigned)(R * K + C) * 2u; voffB[i] = (unsigned)(Rb * K + C) * 2u; }
    const size_t kstep = (size_t)(BK * 2);
    const size_t hstep = (size_t)HALF * K * 2;
    const size_t tstep = 2 * hstep;
    const unsigned ldsw = (unsigned)wid * 1024u;
    const int aoff = lds_byte(wr * 64 + fr, fq * 8), boff = lds_byte(wc * 32 + fr, fq * 8);
#define PG8_SA(b, h) (((b) * 2 + (h)) * HTB)
#define PG8_SB(b, h) ((4 + (b) * 2 + (h)) * HTB)
#define PG8_STAGE(bufoff, gbase, voff) do { _Pragma("unroll") for (int _i = 0; _i < 2; ++_i) \
        __builtin_amdgcn_global_load_lds((const unsigned*)((const char*)(gbase) + (voff)[_i]), (PG8_LAS unsigned*)(lds + (bufoff) + ldsw + _i * 8192), 16, 0, 0); } while (0)
#define PG8_LDA(dst, b, h) do { _Pragma("unroll") for (int m = 0; m < 4; ++m) _Pragma("unroll") for (int k = 0; k < 2; ++k) dst[m][k] = *(const PG8_LAS bf16x8*)(lds + PG8_SA(b, h) + aoff + m * 2048 + k * 1024); } while (0)
#define PG8_LDB(dst, b, h) do { _Pragma("unroll") for (int n = 0; n < 2; ++n) _Pragma("unroll") for (int k = 0; k < 2; ++k) dst[n][k] = *(const PG8_LAS bf16x8*)(lds + PG8_SB(b, h) + boff + n * 2048 + k * 1024); } while (0)
#define PG8_MMA(ai, bj, At, Bt) do { __builtin_amdgcn_s_setprio(1); _Pragma("unroll") for (int m = 0; m < 4; ++m) _Pragma("unroll") for (int n = 0; n < 2; ++n) _Pragma("unroll") for (int k = 0; k < 2; ++k) \
        acc[ai][bj][m][n] = __builtin_amdgcn_mfma_f32_16x16x32_bf16(Bt[n][k], At[m][k], acc[ai][bj][m][n], 0, 0, 0); __builtin_amdgcn_s_setprio(0); } while (0)
#define PG8_WAIT_V(n) asm volatile("s_waitcnt vmcnt(" #n ")" ::: "memory")
#define PG8_WAIT_L(n) asm volatile("s_waitcnt lgkmcnt(" #n ")" ::: "memory")
#define PG8_BAR __builtin_amdgcn_s_barrier()
#define PG8_SCHED __builtin_amdgcn_sched_barrier(0)
    Unit cur, nxt; int ui = 0;
    if (!S.next(0, cur)) return;
    f32x4 acc[2][2][4][2];
#pragma unroll
    for (int a = 0; a < 2; ++a)
#pragma unroll
        for (int b = 0; b < 2; ++b)
#pragma unroll
            for (int m = 0; m < 4; ++m)
#pragma unroll
                for (int n = 0; n < 2; ++n) acc[a][b][m][n] = (f32x4){0.f, 0.f, 0.f, 0.f};
    bf16x8 At[4][2], B0[2][2], B1[2][2];
    const char* cA = (const char*)g.A + (size_t)cur.pm * tstep; const char* cB = (const char*)g.Bt + (size_t)cur.pn * tstep;
    S.a_ready(cur);
    PG8_STAGE(PG8_SB(0, 0), cB, voffB); PG8_STAGE(PG8_SA(0, 0), cA, voffA); PG8_STAGE(PG8_SB(0, 1), cB + hstep, voffB); PG8_STAGE(PG8_SA(0, 1), cA + hstep, voffA);
    if (wr == 1) PG8_BAR;
    PG8_WAIT_V(4); PG8_BAR;
    PG8_STAGE(PG8_SB(1, 0), cB + kstep, voffB); PG8_STAGE(PG8_SA(1, 0), cA + kstep, voffA); PG8_STAGE(PG8_SB(1, 1), cB + hstep + kstep, voffB);
    PG8_WAIT_V(6); PG8_BAR;
    PG8_STAMP();
    for (;;) {
        const bool has_next = S.next(ui + 1, nxt);
        const char* nA = has_next ? (const char*)g.A + (size_t)nxt.pm * tstep : cA; const char* nB = has_next ? (const char*)g.Bt + (size_t)nxt.pn * tstep : cB;
        for (int t = 0; t < nt; t += 2) {
            const bool last = (t == nt - 2);
            const char* a1 = cA + (size_t)(t + 1) * kstep;
            const char* a2 = last ? nA : cA + (size_t)(t + 2) * kstep; const char* b2 = last ? nB : cB + (size_t)(t + 2) * kstep;
            const char* a3 = a2 + kstep; const char* b3 = b2 + kstep;
            if (last && has_next) S.a_ready(nxt);
            PG8_LDB(B0, 0, 0); PG8_SCHED; PG8_LDA(At, 0, 0); PG8_STAGE(PG8_SA(1, 1), a1 + hstep, voffA);
            PG8_WAIT_L(8); PG8_BAR; PG8_WAIT_L(0); PG8_MMA(0, 0, At, B0); PG8_BAR; PG8_SCHED;
            PG8_LDB(B1, 0, 1); PG8_STAGE(PG8_SB(0, 0), b2, voffB);
            PG8_BAR; PG8_WAIT_L(0); PG8_MMA(0, 1, At, B1); PG8_BAR;
            PG8_LDA(At, 0, 1); PG8_STAGE(PG8_SA(0, 0), a2, voffA);
            PG8_BAR; PG8_WAIT_L(0); PG8_MMA(1, 0, At, B0); PG8_BAR; PG8_SCHED;
            PG8_STAGE(PG8_SB(0, 1), b2 + hstep, voffB);
            PG8_WAIT_V(6); PG8_BAR; PG8_MMA(1, 1, At, B1); PG8_BAR;
            PG8_LDB(B0, 1, 0); PG8_SCHED; PG8_LDA(At, 1, 0); PG8_STAGE(PG8_SA(0, 1), a2 + hstep, voffA);
            PG8_WAIT_L(8); PG8_BAR; PG8_WAIT_L(0); PG8_MMA(0, 0, At, B0); PG8_BAR; PG8_SCHED;
            PG8_LDB(B1, 1, 1); PG8_STAGE(PG8_SB(1, 0), b3, voffB);
            PG8_BAR; PG8_WAIT_L(0); PG8_MMA(0, 1, At, B1); PG8_BAR;
            PG8_LDA(At, 1, 1); PG8_STAGE(PG8_SA(1, 0), a3, voffA);
            PG8_BAR; PG8_WAIT_L(0); PG8_MMA(1, 0, At, B0); PG8_BAR; PG8_SCHED;
            PG8_STAGE(PG8_SB(1, 1), b3 + hstep, voffB);
            PG8_WAIT_V(6); PG8_BAR; PG8_MMA(1, 1, At, B1); PG8_BAR;
        }
        PG8_STAMP();
        if constexpr (!Epi::AFTER_DRAIN) { E(acc, cur, wr, wc, fr, fq); S.done(cur); }
        PG8_STAMP();
        if (!has_next) break;
#pragma unroll
        for (int a = 0; a < 2; ++a)
#pragma unroll
            for (int b = 0; b < 2; ++b)
#pragma unroll
                for (int m = 0; m < 4; ++m)
#pragma unroll
                    for (int n = 0; n < 2; ++n) acc[a][b][m][n] = (f32x4){0.f, 0.f, 0.f, 0.f};
        cur = nxt; cA = nA; cB = nB; ++ui;
    }
    PG8_WAIT_V(0);
    if (wr == 0) PG8_BAR;
    PG8_BAR;
    if constexpr (Epi::AFTER_DRAIN) { E.fused(acc, cur, wr, wc, fr, fq, lds, wid, lane); S.done(cur); }
    PG8_STAMP();
    if (STAMP && wid == 0) { stamps[lane] = lane < nts ? (((unsigned long long)(unsigned)ts_hi << 32) | (unsigned)ts_lo) : 0ull;
        if (lane == 62) stamps[62] = rt_entry; if (lane == 63) stamps[63] = (unsigned long long)wall_clock64(); }
#undef PG8_STAMP
#undef PG8_SA
#undef PG8_SB
#undef PG8_STAGE
#undef PG8_LDA
#undef PG8_LDB
#undef PG8_MMA
#undef PG8_WAIT_V
#undef PG8_WAIT_L
#undef PG8_BAR
#undef PG8_SCHED
}
}

struct EpiRowBf16 {
    static constexpr bool PERM = true, AFTER_DRAIN = false;
    u16* O; int ldc;
    DI void operator()(const f32x4 (&acc)[2][2][4][2], const pg8::Unit& u, int wr, int wc, int fr, int fq) const {
        const int row0 = u.pm * 256 + wr * 64 + fr, col0 = u.pn * 256 + wc * 32 + 8 * fq;
#pragma unroll
        for (int ai = 0; ai < 2; ++ai)
#pragma unroll
            for (int m = 0; m < 4; ++m) {
                u16* rowp = O + (size_t)(row0 + ai * 128 + m * 16) * ldc + col0;
#pragma unroll
                for (int bj = 0; bj < 2; ++bj) {
                    const f32x4 v0 = acc[ai][bj][m][0], v1 = acc[ai][bj][m][1];
                    *(u32x4*)(rowp + bj * 128) = (u32x4){cvtpk(v0[0], v0[1]), cvtpk(v0[2], v0[3]), cvtpk(v1[0], v1[1]), cvtpk(v1[2], v1[3])};
                }
            }
    }
};
struct EpiVT {
    static constexpr bool PERM = true, AFTER_DRAIN = false;
    u16* VT;
    DI void operator()(const f32x4 (&acc)[2][2][4][2], const pg8::Unit& u, int wr, int wc, int fr, int fq) const {
        const int ch0 = u.pm * 256 + wr * 64 + fr, tok0 = u.pn * 256 + wc * 32 + 8 * fq;
        const int b = tok0 >> 12, t0 = tok0 & 4095;
#pragma unroll
        for (int ai = 0; ai < 2; ++ai)
#pragma unroll
            for (int m = 0; m < 4; ++m) {
                u16* rowp = VT + ((size_t)b * NVT + ch0 + ai * 128 + m * 16) * SEQ + t0;
#pragma unroll
                for (int bj = 0; bj < 2; ++bj) {
                    const f32x4 v0 = acc[ai][bj][m][0], v1 = acc[ai][bj][m][1];
                    *(u32x4*)(rowp + bj * 128) = (u32x4){cvtpk(v0[0], v0[1]), cvtpk(v0[2], v0[3]), cvtpk(v1[0], v1[1]), cvtpk(v1[2], v1[3])};
                }
            }
    }
};
template <bool FIRST>
struct EpiRes {
    static constexpr bool PERM = true, AFTER_DRAIN = false;
    const float* X; u16* Y; const float* stats; const float* lg; const float* lb; const float* gate;
    DI void operator()(const f32x4 (&acc)[2][2][4][2], const pg8::Unit& u, int wr, int wc, int fr, int fq) const {
        const int row0 = u.pm * 256 + wr * 64 + fr, col0 = u.pn * 256 + wc * 32 + 8 * fq;
        const float* gb = gate + (size_t)(u.pm >> 4) * 3072;
#pragma unroll
        for (int bj = 0; bj < 2; ++bj) {
            const int c = col0 + bj * 128;
            float gp[8], ag[8], ab[8];
#pragma unroll
            for (int n = 0; n < 2; ++n) {
                const f32x4 t = *(const f32x4*)(gb + c + 4 * n);
#pragma unroll
                for (int j = 0; j < 4; ++j) gp[4 * n + j] = 1.f + t[j];
                if (!FIRST) {
                    const f32x4 g4 = *(const f32x4*)(lg + c + 4 * n), b4 = *(const f32x4*)(lb + c + 4 * n);
#pragma unroll
                    for (int j = 0; j < 4; ++j) { ag[4 * n + j] = ALPHA_RES * g4[j]; ab[4 * n + j] = ALPHA_RES * b4[j]; }
                }
            }
            constexpr int GR = 4;
#pragma unroll
            for (int g0 = 0; g0 < 8; g0 += GR) {
                u32x4 yv[GR]; f32x2_t st[GR]; f32x4 x0[GR], x1[GR];
#pragma unroll
                for (int i = 0; i < GR; ++i) {
                    const int ai = (g0 + i) >> 2, m = (g0 + i) & 3;
                    const size_t row = (size_t)(row0 + ai * 128 + m * 16);
                    if (FIRST) { x0[i] = *(const f32x4*)(X + row * 1024 + c); x1[i] = *(const f32x4*)(X + row * 1024 + c + 4); }
                    else { yv[i] = *(const u32x4*)(Y + row * 1024 + c); st[i] = *(const f32x2_t*)(stats + row * 2); }
                }
#pragma unroll
                for (int i = 0; i < GR; ++i) {
                    const int ai = (g0 + i) >> 2, m = (g0 + i) & 3;
                    const size_t row = (size_t)(row0 + ai * 128 + m * 16);
                    float xa[8];
                    if (FIRST) {
#pragma unroll
                        for (int j = 0; j < 4; ++j) { xa[j] = ALPHA_RES * x0[i][j]; xa[4 + j] = ALPHA_RES * x1[i][j]; }
                    } else {
                        const float rs = st[i][1], nm = -st[i][0] * st[i][1];
#pragma unroll
                        for (int q = 0; q < 4; ++q) {
                            xa[2 * q] = fmaf(fmaf(bflo(yv[i][q]), rs, nm), ag[2 * q], ab[2 * q]);
                            xa[2 * q + 1] = fmaf(fmaf(bfhi(yv[i][q]), rs, nm), ag[2 * q + 1], ab[2 * q + 1]);
                        }
                    }
                    float o[8];
#pragma unroll
                    for (int n = 0; n < 2; ++n)
#pragma unroll
                        for (int j = 0; j < 4; ++j) o[4 * n + j] = fmaf(gp[4 * n + j], acc[ai][bj][m][n][j], xa[4 * n + j]);
                    *(u32x4*)(Y + row * 1024 + c) = (u32x4){cvtpk(o[0], o[1]), cvtpk(o[2], o[3]), cvtpk(o[4], o[5]), cvtpk(o[6], o[7])};
                }
            }
        }
    }
};
struct EpiSwiglu {
    static constexpr bool PERM = true, AFTER_DRAIN = false;
    u16* ACT;
    DI void operator()(const f32x4 (&acc)[2][2][4][2], const pg8::Unit& u, int wr, int wc, int fr, int fq) const {
        const int row0 = u.pm * 256 + wr * 64 + fr, j0 = u.pn * 128 + wc * 32 + 8 * fq;
#pragma unroll
        for (int ai = 0; ai < 2; ++ai)
#pragma unroll
            for (int m = 0; m < 4; ++m) {
                float v[8];
#pragma unroll
                for (int n = 0; n < 2; ++n)
#pragma unroll
                    for (int j = 0; j < 4; ++j) { const float gq = acc[ai][0][m][n][j]; v[4 * n + j] = (gq * acc[ai][1][m][n][j]) * __builtin_amdgcn_rcpf(1.f + fexp2(gq)); }
                *(u32x4*)(ACT + (size_t)(row0 + ai * 128 + m * 16) * FF + j0) = (u32x4){cvtpk(v[0], v[1]), cvtpk(v[2], v[3]), cvtpk(v[4], v[5]), cvtpk(v[6], v[7])};
            }
    }
};
struct EpiIn1 {
    static constexpr bool PERM = true, AFTER_DRAIN = false;
    u16* B1; u16* CZ;
    DI void operator()(const f32x4 (&acc)[2][2][4][2], const pg8::Unit& u, int wr, int wc, int fr, int fq) const {
        const int row0 = u.pm * 256 + wr * 64 + fr;
        if (u.pn < 4) {
            const int col0 = u.pn * 256 + wc * 32 + 8 * fq;
#pragma unroll
            for (int ai = 0; ai < 2; ++ai)
#pragma unroll
                for (int m = 0; m < 4; ++m) {
                    u16* rowp = B1 + (size_t)(row0 + ai * 128 + m * 16) * 1024 + col0;
#pragma unroll
                    for (int bj = 0; bj < 2; ++bj) {
                        const f32x4 v0 = acc[ai][bj][m][0], v1 = acc[ai][bj][m][1];
                        *(u32x4*)(rowp + bj * 128) = (u32x4){cvtpk(v0[0], v0[1]), cvtpk(v0[2], v0[3]), cvtpk(v1[0], v1[1]), cvtpk(v1[2], v1[3])};
                    }
                }
        } else {
            const int j0 = (u.pn - 4) * 128 + wc * 32 + 8 * fq;
#pragma unroll
            for (int ai = 0; ai < 2; ++ai)
#pragma unroll
                for (int m = 0; m < 4; ++m) {
                    const f32x4 v0 = acc[ai][0][m][0] * acc[ai][1][m][0], v1 = acc[ai][0][m][1] * acc[ai][1][m][1];
                    *(u32x4*)(CZ + (size_t)(row0 + ai * 128 + m * 16) * 1024 + j0) = (u32x4){cvtpk(v0[0], v0[1]), cvtpk(v0[2], v0[3]), cvtpk(v1[0], v1[1]), cvtpk(v1[2], v1[3])};
                }
        }
    }
};
template <class Epi>
DI void run_gemm(PG8_LAS unsigned char* lds, const u16* A, const u16* Bt, int M, int N, int K, const Epi& E) {
    pg8::Gemm g{A, Bt, M, N, K};
    pg8::StaticOrder S; S.init(M, N, (int)gridDim.x, (int)blockIdx.x);
    pg8::gemm_phase<Epi, pg8::StaticOrder, false>(lds, g, S, E, nullptr);
}

DI void compress_item(const Params& p, int item, char* lds) {
    const int which = item >> 6, g = (item >> 5) & 1, mt = item & 31;
    const int tid = TIDX, lane = tid & 63, w = tid >> 6, wm = w >> 1, wn = w & 1, r = lane & 31, h = lane >> 5;
    const u16* PR = (const u16*)(p.ws + WS_PR);
    const u16* A = PR + (size_t)mt * 128 * 16 * LDP + (which ? 640 : 512) + g * 64;
    const u16* Bt = (const u16*)(p.ws + WS_W1T) + (size_t)which * 128 * 2048;
    f32x16 acc[2][2]; zero_acc(acc);
    gemm_main_pf2<true>(A, 16 * LDP, LDP, Bt, 2048, 32, lds, acc);
    const float* b1p = (const float*)(p.ws + WS_B1P) + which * 16 * 128;
#pragma unroll
    for (int ni = 0; ni < 2; ++ni)
#pragma unroll
        for (int a = 0; a < 4; ++a) {
            const int j0 = wn * 64 + ni * 32 + 8 * a + 4 * h;
            float bias[4] = {0.f, 0.f, 0.f, 0.f};
            for (int c = 0; c < 16; ++c) {
                const f32x4 t = *(const f32x4*)(b1p + c * 128 + j0);
                bias[0] += t[0]; bias[1] += t[1]; bias[2] += t[2]; bias[3] += t[3];
            }
#pragma unroll
            for (int mi = 0; mi < 2; ++mi) {
                const int m = wm * 64 + mi * 32 + r;
                float v[4];
#pragma unroll
                for (int j = 0; j < 4; ++j) v[j] = geluf_(acc[mi][ni][4 * a + j] + bias[j]);
                const int chunk = (j0 >> 3) ^ (m & 15);
                *(u32x2*)(lds + m * 256 + chunk * 16 + (j0 & 7) * 2) = (u32x2){cvtpk(v[0], v[1]), cvtpk(v[2], v[3])};
            }
        }
    __syncthreads();
    const u16* W2 = (const u16*)(p.ws + WS_W2T) + which * 64 * 128;
    f32x16 o2[2];
#pragma unroll
    for (int i = 0; i < 16; ++i) { o2[0][i] = 0.f; o2[1][i] = 0.f; }
    const int mrow = 32 * w + r;
#pragma unroll
    for (int ks = 0; ks < 8; ++ks) {
        const bf16x8 hf = *(const bf16x8*)(lds + mrow * 256 + (((ks * 2 + h) ^ (mrow & 15)) << 4));
#pragma unroll
        for (int et = 0; et < 2; ++et) {
            const bf16x8 wf = *(const bf16x8*)(W2 + (et * 32 + r) * 128 + ks * 16 + 8 * h);
            o2[et] = which ? MFMA(hf, wf, o2[et]) : MFMA(wf, hf, o2[et]);
        }
    }
    const int bg_base = (mt >> 1);
    const int nbase = (mt & 1) * 128 + 32 * w;
    const int kbc = (mt & 1) * 4 + w;
    const size_t fbase = ((size_t)(bg_base * 2 + g) * 8 + kbc) * 2048;
    if (which == 0) {
        u16* kc = (u16*)(p.ws + WS_KCMP) + fbase;
        const bool zero = (kbc == 7) && (r == 31);
#pragma unroll
        for (int et = 0; et < 2; ++et)
#pragma unroll
            for (int a = 0; a < 4; ++a) {
                u32x2 v = (u32x2){cvtpk(o2[et][4 * a], o2[et][4 * a + 1]), cvtpk(o2[et][4 * a + 2], o2[et][4 * a + 3])};
                if (zero) v = (u32x2){0u, 0u};
                *(u32x2*)(kc + ((et * 2 + (a >> 1)) * 64 + (a & 1) * 32 + r) * 8 + 4 * h) = v;
            }
    } else {
        u16* vt = (u16*)(p.ws + WS_VCMPT) + fbase;
#pragma unroll
        for (int et = 0; et < 2; ++et)
#pragma unroll
            for (int a = 0; a < 4; ++a) {
                float v3 = o2[et][4 * a + 3];
                if (kbc == 7 && a == 3 && h == 1) v3 = 0.f;
                *(u32x2*)(vt + (((a >> 1) * 2 + et) * 64 + h * 32 + r) * 8 + 4 * (a & 1)) = (u32x2){cvtpk(o2[et][4 * a], o2[et][4 * a + 1]), cvtpk(o2[et][4 * a + 2], v3)};
            }
    }
    __syncthreads();
}

DI void gmlp_item(const Params& p, int item, char* lds) {
    const int grp = item & 7, chunk = (item >> 3) & 31, b = item >> 8;
    const int tid = TIDX, lane = tid & 63, w = tid >> 6, r = lane & 31, h = lane >> 5;
    const u16* VT = (const u16*)(p.ws + WS_VT) + ((size_t)b * NVT + 256 + grp * 64) * SEQ + chunk * 128;
#pragma unroll
    for (int i = 0; i < 4; ++i) {
        const int id = tid + 256 * i, d = id >> 4, c = id & 15;
        *(u32x4*)(lds + d * 256 + ((c ^ (d & 15)) << 4)) = *(const u32x4*)(VT + (size_t)d * SEQ + c * 8);
    }
    const int nks = 2 * (w + 1);
    bf16x8 wfr[8];
    {
        const u16* Wt = (const u16*)(p.ws + WS_TRIL) + (size_t)grp * 128 * 128 + (32 * w + r) * 128 + 8 * h;
#pragma unroll
        for (int ks = 0; ks < 8; ++ks) wfr[ks] = (ks < nks) ? *(const bf16x8*)(Wt + ks * 16) : (bf16x8){0, 0, 0, 0, 0, 0, 0, 0};
    }
    const int t = 32 * w + r;
    const size_t tok = (size_t)b * SEQ + chunk * 128 + t;
    const float bs = p.gmlp_bs[grp * 128 + t];
    const u16* up = (const u16*)(p.ws + WS_PR) + tok * LDP + 1024 + grp * 64 + 4 * h;
    u32x2 uu[2][4];
#pragma unroll
    for (int dt = 0; dt < 2; ++dt)
#pragma unroll
        for (int a = 0; a < 4; ++a) uu[dt][a] = *(const u32x2*)(up + dt * 32 + 8 * a);
    __syncthreads();
    {
        float* red = (float*)(lds + 16384);
        const int s = tid & 127, dh = tid >> 7;
        float v[32]; float sum = 0.f;
#pragma unroll
        for (int i = 0; i < 32; ++i) {
            const int d = dh * 32 + i;
            const u16 raw = *(const u16*)(lds + d * 256 + ((((s >> 3)) ^ (d & 15)) << 4) + (s & 7) * 2);
            v[i] = geluf_(bf2f(raw)); sum += v[i];
        }
        red[dh * 128 + s] = sum;
        __syncthreads();
        const float mu = (red[s] + red[128 + s]) * (1.f / 64.f);
        float sq = 0.f;
#pragma unroll
        for (int i = 0; i < 32; ++i) { const float dlt = v[i] - mu; sq += dlt * dlt; }
        __syncthreads();
        red[dh * 128 + s] = sq;
        __syncthreads();
        const float rstd = rsqrtf((red[s] + red[128 + s]) * (1.f / 64.f) + 1e-5f);
        const float* ng = p.gmlp_norm_g + grp * 64 + dh * 32;
#pragma unroll
        for (int i = 0; i < 32; ++i) {
            const int d = dh * 32 + i;
            const float y = (v[i] - mu) * rstd * ng[i];
            const unsigned pk = cvtpk(y, 0.f);
            *(u16*)(lds + d * 256 + ((((s >> 3)) ^ (d & 15)) << 4) + (s & 7) * 2) = (u16)(pk & 0xffffu);
        }
    }
    __syncthreads();
    f32x16 x[2];
#pragma unroll
    for (int i = 0; i < 16; ++i) { x[0][i] = 0.f; x[1][i] = 0.f; }
#pragma unroll
    for (int ks = 0; ks < 8; ++ks) {
        if (ks < nks) {
#pragma unroll
            for (int dt = 0; dt < 2; ++dt) {
                const int d = dt * 32 + r;
                const bf16x8 vf = *(const bf16x8*)(lds + d * 256 + (((ks * 2 + h) ^ (d & 15)) << 4));
                x[dt] = MFMA(vf, wfr[ks], x[dt]);
            }
        }
    }
    u16* op = (u16*)(p.ws + WS_MIX) + tok * 1024 + 512 + grp * 64 + 4 * h;
#pragma unroll
    for (int dt = 0; dt < 2; ++dt)
#pragma unroll
        for (int a = 0; a < 4; ++a) {
            const float u0 = geluf_(bflo(uu[dt][a][0])), u1 = geluf_(bfhi(uu[dt][a][0])), u2 = geluf_(bflo(uu[dt][a][1])), u3 = geluf_(bfhi(uu[dt][a][1]));
            *(u32x2*)(op + dt * 32 + 8 * a) = (u32x2){cvtpk(u0 * (x[dt][4 * a] + bs), u1 * (x[dt][4 * a + 1] + bs)), cvtpk(u2 * (x[dt][4 * a + 2] + bs), u3 * (x[dt][4 * a + 3] + bs))};
        }
    __syncthreads();
}


DI void repack_item(const Params& p, int item) {
    const int tid = TIDX, x = tid >> 6, lane = tid & 63, r = lane & 31, h = lane >> 5;
    const int kb0 = (item & 15) * 8, bg = (item >> 4) & 31, tensor = item >> 9, b = bg >> 1, g = bg & 1;
    const size_t dsto = ((((size_t)bg * 128 + kb0) * 4 + x) * 64 + lane) * 8;
    u32x4 v[8];
    if (tensor < 2) {
        const u16* src = (const u16*)(p.ws + WS_PR) + ((size_t)b * SEQ + kb0 * 32 + r) * LDP + (tensor ? 896 : 768) + g * 64 + x * 16 + 8 * h;
#pragma unroll
        for (int i = 0; i < 8; ++i) v[i] = *(const u32x4*)(src + (size_t)i * 32 * LDP);
    } else {
        const int s2 = x >> 1, dt = x & 1;
        const u16* vp = (const u16*)(p.ws + WS_VT) + ((size_t)b * NVT + (tensor == 3 ? 128 : 0) + g * 64 + dt * 32 + r) * SEQ + kb0 * 32 + 16 * s2 + 4 * h;
#pragma unroll
        for (int i = 0; i < 8; ++i) { const u32x2 lo = *(const u32x2*)(vp + i * 32), hi = *(const u32x2*)(vp + i * 32 + 8); v[i] = (u32x4){lo[0], lo[1], hi[0], hi[1]}; }
    }
    u16* dst = (u16*)(p.ws + (tensor == 0 ? WS_KSF : tensor == 1 ? WS_KWF : tensor == 2 ? WS_VSF : WS_VWF)) + dsto;
#pragma unroll
    for (int i = 0; i < 8; ++i) *(u32x4*)(dst + (size_t)i * 2048) = v[i];
}

DI f32x16 qk_tile(const u16* __restrict__ Kb, long ldk, int key0, const bf16x8 (&qf)[4], int r, int h) {
    const u16* kp = Kb + (long)(key0 + r) * ldk + 8 * h;
    f32x16 s;
#pragma unroll
    for (int i = 0; i < 16; ++i) s[i] = 0.f;
#pragma unroll
    for (int ks = 0; ks < 4; ++ks) { const bf16x8 kf = *(const bf16x8*)(kp + ks * 16); s = MFMA(kf, qf[ks], s); }
    return s;
}
DI void pv_tile(const u16* __restrict__ Vt, long ldv, int key0, const float (&pr)[16], f32x16 (&o)[2], int r, int h) {
#pragma unroll
    for (int s2 = 0; s2 < 2; ++s2) {
        const u32x4 pk = (u32x4){cvtpk(pr[8 * s2], pr[8 * s2 + 1]), cvtpk(pr[8 * s2 + 2], pr[8 * s2 + 3]), cvtpk(pr[8 * s2 + 4], pr[8 * s2 + 5]), cvtpk(pr[8 * s2 + 6], pr[8 * s2 + 7])};
        const bf16x8 pb = __builtin_bit_cast(bf16x8, pk);
#pragma unroll
        for (int dt = 0; dt < 2; ++dt) {
            const u16* vp = Vt + (long)(dt * 32 + r) * ldv + key0 + 16 * s2 + 4 * h;
            const u32x2 lo = *(const u32x2*)vp, hi = *(const u32x2*)(vp + 8);
            const bf16x8 vf = __builtin_bit_cast(bf16x8, (u32x4){lo[0], lo[1], hi[0], hi[1]});
            o[dt] = MFMA(vf, pb, o[dt]);
        }
    }
}
struct KVF { bf16x8 k[4]; bf16x8 v[4]; };
DI void load_konly(KVF& f, const u16* __restrict__ Kf, int kb, int lane) {
    const u16* kp = Kf + (size_t)kb * 2048 + lane * 8;
#pragma unroll
    for (int ks = 0; ks < 4; ++ks) f.k[ks] = *(const bf16x8*)(kp + ks * 512);
}
DI void load_k(KVF& f, const u16* __restrict__ Kf, const u16* __restrict__ Vf, int kb, int lane) {
    const u16* kp = Kf + (size_t)kb * 2048 + lane * 8;
    const u16* vp = Vf + (size_t)kb * 2048 + lane * 8;
#pragma unroll
    for (int ks = 0; ks < 4; ++ks) f.k[ks] = *(const bf16x8*)(kp + ks * 512);
#pragma unroll
    for (int x = 0; x < 4; ++x) f.v[x] = *(const bf16x8*)(vp + x * 512);
}
template <class VF>
DI void attend_block(const KVF& f, const bf16x8 (&qs)[4], bool masked, VF valid, bool lanesel, bool first, float& m, float& l, f32x16 (&o)[2]) {
    const float NI = -__builtin_inff();
    const float init = lanesel ? -m : NI;
    f32x16 sv;
#pragma unroll
    for (int i = 0; i < 16; ++i) sv[i] = init;
#pragma unroll
    for (int ks = 0; ks < 4; ++ks) sv = MFMA(f.k[ks], qs[ks], sv);
    float s[16];
    if (masked) {
#pragma unroll
        for (int i = 0; i < 16; ++i) s[i] = valid(i) ? sv[i] : NI;
    } else {
#pragma unroll
        for (int i = 0; i < 16; ++i) s[i] = sv[i];
    }
    float mx = s[0];
#pragma unroll
    for (int i = 1; i < 16; ++i) mx = fmaxf(mx, s[i]);
    if (first) {
        mx = fmaxf(mx, __shfl_xor(mx, 32));
        const float d = (mx > NI) ? mx : 0.f;
        m = d;
#pragma unroll
        for (int i = 0; i < 16; ++i) s[i] -= d;
    } else if (__ballot(mx > 8.f)) {
        mx = fmaxf(mx, __shfl_xor(mx, 32));
        const float d = fmaxf(mx, 0.f), al = fexp2(-d);
        l *= al; m += d;
#pragma unroll
        for (int i = 0; i < 16; ++i) { o[0][i] *= al; o[1][i] *= al; s[i] -= d; }
    }
#pragma unroll
    for (int i = 0; i < 16; ++i) s[i] = fexp2(s[i]);
    const bf16x2_t ones = __builtin_bit_cast(bf16x2_t, 0x3f803f80u);
    float ps = 0.f;
#pragma unroll
    for (int s2 = 0; s2 < 2; ++s2) {
        const u32x4 pk = (u32x4){cvtpk(s[8 * s2], s[8 * s2 + 1]), cvtpk(s[8 * s2 + 2], s[8 * s2 + 3]), cvtpk(s[8 * s2 + 4], s[8 * s2 + 5]), cvtpk(s[8 * s2 + 6], s[8 * s2 + 7])};
#pragma unroll
        for (int q = 0; q < 8; ++q) ps += s[8 * s2 + q];
        const bf16x8 pb = __builtin_bit_cast(bf16x8, pk);
#pragma unroll
        for (int dt = 0; dt < 2; ++dt) o[dt] = MFMA(f.v[s2 * 2 + dt], pb, o[dt]);
    }
    l += ps;
}
template <class NextF, class MaskF, class ValidF, class LaneF>
DI void attend_range(const u16* __restrict__ Kf, const u16* __restrict__ Vf, int first, int last, NextF next, MaskF maskedf, ValidF validf, LaneF lanef,
                     const bf16x8 (&qf)[4], int lane, float& m, float& l, f32x16 (&o)[2]) {
    int kb = first;
    if (kb > last) return;
    KVF A, B;
    bool fst = true;
    load_k(A, Kf, Vf, kb, lane);
#pragma unroll 1
    for (;;) {
        int nk = next(kb);
        load_k(B, Kf, Vf, nk <= last ? nk : last, lane);
        attend_block(A, qf, maskedf(kb), [&](int i) { return validf(kb, i); }, lanef(kb), fst, m, l, o);
        fst = false;
        if (nk > last) break;
        kb = nk;
        nk = next(kb);
        load_k(A, Kf, Vf, nk <= last ? nk : last, lane);
        attend_block(B, qf, maskedf(kb), [&](int i) { return validf(kb, i); }, lanef(kb), false, m, l, o);
        if (nk > last) break;
        kb = nk;
    }
}

DI void nsa_item(const Params& p, int item, char* lds) {
    const int qt = 127 - (item >> 5), bg = item & 31, b = bg >> 1, g = bg & 1;
    int tid = TIDX;
    asm volatile("" : "+v"(tid));
    const int lane = tid & 63, w = tid >> 6, r = lane & 31, h = lane >> 5;
    const int q0 = qt * 32, hq = g * 4 + w, tq = q0 + r;
    const size_t tokb = (size_t)b * SEQ;
    const u16* PR = (const u16*)(p.ws + WS_PR);
    const u16* VT = (const u16*)(p.ws + WS_VT);
    const float SC = 0.125f * 1.4426950408889634f;
    const float NINF = -__builtin_inff();
    bf16x8 qf[4];
    {
        const u16* qp = PR + (tokb + tq) * LDP + hq * 64 + 8 * h;
#pragma unroll
        for (int ks = 0; ks < 4; ++ks) qf[ks] = *(const bf16x8*)(qp + ks * 16);
    }
    float* slab = (float*)lds;
    unsigned long long* masks = (unsigned long long*)(lds + 33280);
    unsigned* uni = (unsigned*)(lds + 33280 + 256);

    float* stash = (float*)(lds + 34816) + w * 2048 + lane;
    {
        const u16* Kc = (const u16*)(p.ws + WS_KCMP) + (size_t)(b * 2 + g) * 8 * 2048;
        const u16* Vc = (const u16*)(p.ws + WS_VCMPT) + (size_t)(b * 2 + g) * 8 * 2048;
        const int nkb = (q0 >> 9) + 1;
        float m = -1e30f, l = 0.f;
        auto qk = [&](const KVF& f) { f32x16 sv;
#pragma unroll
            for (int i = 0; i < 16; ++i) sv[i] = 0.f;
#pragma unroll
            for (int ks = 0; ks < 4; ++ks) sv = MFMA(f.k[ks], qf[ks], sv);
            return sv; };
        auto pass1 = [&](const KVF& f, int kb) {
            const f32x16 sv = qk(f);
            float s[16];
#pragma unroll
            for (int i = 0; i < 16; ++i) { const int n = kb * 32 + crow(i, h); s[i] = (16 * n + 31 <= tq) ? sv[i] * SC : NINF; }
            float mx = s[0];
#pragma unroll
            for (int i = 1; i < 16; ++i) mx = fmaxf(mx, s[i]);
            mx = fmaxf(mx, __shfl_xor(mx, 32));
            const float mn = fmaxf(m, mx);
            float ps = 0.f;
#pragma unroll
            for (int i = 0; i < 16; ++i) ps += fexp2(s[i] - mn);
            l = l * fexp2(m - mn) + ps; m = mn;
        };
        {
            KVF A, B;
            load_konly(A, Kc, 0, lane);
#pragma unroll 1
            for (int kb = 0; kb < nkb; kb += 2) {
                load_konly(B, Kc, kb + 1 < nkb ? kb + 1 : nkb - 1, lane);
                pass1(A, kb);
                if (kb + 1 >= nkb) break;
                load_konly(A, Kc, kb + 2 < nkb ? kb + 2 : nkb - 1, lane);
                pass1(B, kb + 1);
            }
        }
        l += __shfl_xor(l, 32);
        const float inv = (l > 0.f) ? 1.f / l : 0.f;
        f32x16 oc[2];
#pragma unroll
        for (int i = 0; i < 16; ++i) { oc[0][i] = 0.f; oc[1][i] = 0.f; }
        float carry = 0.f;
        float* myslab = slab + (w * 32 + r) * 65;
        auto pass2 = [&](const KVF& f, int kb) {
            const f32x16 sv = qk(f);
            float pr[16];
#pragma unroll
            for (int i = 0; i < 16; ++i) { const int n = kb * 32 + crow(i, h); pr[i] = (16 * n + 31 <= tq) ? fexp2(sv[i] * SC - m) * inv : 0.f; }
            float xs[4];
#pragma unroll
            for (int a = 0; a < 4; ++a) xs[a] = __shfl_xor(pr[4 * a + 3], 32);
#pragma unroll
            for (int a = 0; a < 4; ++a) {
                const float sum = pr[4 * a] + pr[4 * a + 1] + pr[4 * a + 2] + pr[4 * a + 3];
                const float prev = h ? xs[a] : (a == 0 ? carry : xs[a > 0 ? a - 1 : 0]);
                myslab[8 * kb + 2 * a + h] = sum + prev;
            }
            carry = xs[3];
#pragma unroll
            for (int s2 = 0; s2 < 2; ++s2) {
                const u32x4 pk = (u32x4){cvtpk(pr[8 * s2], pr[8 * s2 + 1]), cvtpk(pr[8 * s2 + 2], pr[8 * s2 + 3]), cvtpk(pr[8 * s2 + 4], pr[8 * s2 + 5]), cvtpk(pr[8 * s2 + 6], pr[8 * s2 + 7])};
                const bf16x8 pb = __builtin_bit_cast(bf16x8, pk);
#pragma unroll
                for (int dt = 0; dt < 2; ++dt) oc[dt] = MFMA(f.v[s2 * 2 + dt], pb, oc[dt]);
            }
        };
        {
            KVF A, B;
            load_k(A, Kc, Vc, 0, lane);
#pragma unroll 1
            for (int kb = 0; kb < nkb; kb += 2) {
                load_k(B, Kc, Vc, kb + 1 < nkb ? kb + 1 : nkb - 1, lane);
                pass2(A, kb);
                if (kb + 1 >= nkb) break;
                load_k(A, Kc, Vc, kb + 2 < nkb ? kb + 2 : nkb - 1, lane);
                pass2(B, kb + 1);
            }
        }
#pragma unroll 1
        for (int kb = nkb; kb < 8; ++kb) {
#pragma unroll
            for (int a = 0; a < 4; ++a) myslab[8 * kb + 2 * a + h] = 0.f;
        }
        const u16* gp = PR + (tokb + tq) * LDP + 1536 + hq * 3;
        const float g0 = sigmoidf_(bf2f(gp[0]));
#pragma unroll
        for (int i = 0; i < 16; ++i) { stash[i * 64] = g0 * oc[0][i]; stash[(16 + i) * 64] = g0 * oc[1][i]; }
    }
    __syncthreads();
    for (int e = tid; e < 2048; e += 256) {
        const int q = e >> 6, j = e & 63;
        const float v = slab[(0 * 32 + q) * 65 + j] + slab[(1 * 32 + q) * 65 + j] + slab[(2 * 32 + q) * 65 + j] + slab[(3 * 32 + q) * 65 + j];
        const int t = q0 + q, cur = t >> 6;
        const bool forced = (j == 0) | (j == cur) | (j == cur - 1);
        const bool valid = (j * 64 <= t);
        const float vv = forced ? 1e4f : v;
        const unsigned key = (forced || valid) ? ((((__float_as_uint(vv) >> 6) + 1u) << 6) | (unsigned)(63 - j)) : (unsigned)(63 - j);
        slab[q * 65 + j] = __uint_as_float(key);
    }
    if (tid == 0) { uni[0] = 0u; uni[1] = 0u; uni[2] = 0xffffffffu; uni[3] = 0xffffffffu; }
    __syncthreads();
#pragma unroll 1
    for (int qq = 0; qq < 8; ++qq) {
        const int q = w * 8 + qq;
        const unsigned key = __float_as_uint(slab[q * 65 + lane]);
        unsigned T = 0u;
#pragma unroll
        for (int bit = 30; bit >= 0; --bit) {
            const unsigned cand = T | (1u << bit);
            if (__builtin_popcountll(__ballot(key >= cand)) >= 16) T = cand;
        }
        const unsigned long long mk = __ballot(key >= T);
        if (lane == 0) { masks[q] = mk; atomicOr(&uni[0], (unsigned)mk); atomicOr(&uni[1], (unsigned)(mk >> 32)); atomicAnd(&uni[2], (unsigned)mk); atomicAnd(&uni[3], (unsigned)(mk >> 32)); }
    }
    __syncthreads();
    bf16x8 qs[4];
#pragma unroll
    for (int ks = 0; ks < 4; ++ks) {
        const u32x4 t = __builtin_bit_cast(u32x4, qf[ks]); u32x4 o4;
#pragma unroll
        for (int q = 0; q < 4; ++q) o4[q] = cvtpk(bflo(t[q]) * SC, bfhi(t[q]) * SC);
        qs[ks] = __builtin_bit_cast(bf16x8, o4);
    }
    const unsigned long long mymask = masks[r];
    const unsigned long long umask = ((unsigned long long)(unsigned)__builtin_amdgcn_readfirstlane((int)uni[1]) << 32) | (unsigned)__builtin_amdgcn_readfirstlane((int)uni[0]);
    const unsigned long long amask = ((unsigned long long)(unsigned)__builtin_amdgcn_readfirstlane((int)uni[3]) << 32) | (unsigned)__builtin_amdgcn_readfirstlane((int)uni[2]);
    {
        const u16* Ks = (const u16*)(p.ws + WS_KSF) + (size_t)(b * 2 + g) * 128 * 2048;
        const u16* VsT = (const u16*)(p.ws + WS_VSF) + (size_t)(b * 2 + g) * 128 * 2048;
        f32x16 o[2];
#pragma unroll
        for (int i = 0; i < 16; ++i) { o[0][i] = 0.f; o[1][i] = 0.f; }
        float m = 0.f, l = 0.f;
        attend_range(Ks, VsT, 0, qt,
            [&](int kb) { int n = kb + 1; const int j = n >> 1; const unsigned long long rest = umask >> j; if (rest == 0ull) return qt + 1; const int sk = __builtin_ctzll(rest); if (sk > 0) n = (j + sk) * 2; return n; },
            [&](int kb) { return kb == qt; },
            [&](int kb, int i) { return kb * 32 + crow(i, h) <= tq; },
            [&](int kb) { return (bool)((mymask >> (kb >> 1)) & 1ull); },
            qs, lane, m, l, o);
        l += __shfl_xor(l, 32);
        const u16* gp = PR + (tokb + tq) * LDP + 1536 + hq * 3;
        const float g1 = sigmoidf_(bf2f(gp[1])) * ((l > 0.f) ? 1.f / l : 0.f);
#pragma unroll
        for (int i = 0; i < 16; ++i) { stash[i * 64] += g1 * o[0][i]; stash[(16 + i) * 64] += g1 * o[1][i]; }
    }
    f32x16 fin[2];
    {
        const u16* Kw = (const u16*)(p.ws + WS_KWF) + (size_t)(b * 2 + g) * 128 * 2048;
        const u16* VwT = (const u16*)(p.ws + WS_VWF) + (size_t)(b * 2 + g) * 128 * 2048;
        f32x16 o[2];
#pragma unroll
        for (int i = 0; i < 16; ++i) { o[0][i] = 0.f; o[1][i] = 0.f; }
        float m = 0.f, l = 0.f;
        const int kb0 = (qt - 16 > 0) ? qt - 16 : 0;
        attend_range(Kw, VwT, kb0, qt,
            [&](int kb) { return kb + 1; },
            [&](int kb) { return (kb == qt) || (kb == qt - 16); },
            [&](int kb, int i) { const int key = kb * 32 + crow(i, h); return (key <= tq) && (key + 512 > tq); },
            [&](int kb) { return true; },
            qs, lane, m, l, o);
        l += __shfl_xor(l, 32);
        const u16* gp = PR + (tokb + tq) * LDP + 1536 + hq * 3;
        const float g2 = sigmoidf_(bf2f(gp[2])) * ((l > 0.f) ? 1.f / l : 0.f);
#pragma unroll
        for (int i = 0; i < 16; ++i) { fin[0][i] = stash[i * 64] + g2 * o[0][i]; fin[1][i] = stash[(16 + i) * 64] + g2 * o[1][i]; }
    }
    u16* op = (u16*)(p.ws + WS_MIX) + (tokb + tq) * 1024 + hq * 64 + 4 * h;
#pragma unroll
    for (int dt = 0; dt < 2; ++dt)
#pragma unroll
        for (int a = 0; a < 4; ++a)
            *(u32x2*)(op + dt * 32 + 8 * a) = (u32x2){cvtpk(fin[dt][4 * a], fin[dt][4 * a + 1]), cvtpk(fin[dt][4 * a + 2], fin[dt][4 * a + 3])};
}

template <bool LAST>
DI void phase_ln(const Params& p, int k) {
    const u16* Y = (const u16*)(p.ws + WS_XY);
    float* stats = (float*)(p.ws + WS_STATS);
    u16* H = (u16*)(p.ws + WS_H);
    int lane = TIDX & 63; const int w = TIDX >> 6;
    asm volatile("" : "+v"(lane));
    const int col = lane * 16;
    const int nwaves = VGRD * 4, rpw = NT_TOK / nwaves;
    const int wid = VBLK * 4 + w;
    float A[16], Bc[16];
    {
        const float* lg = p.ln_g + k * 1024 + col; const float* lb = p.ln_b + k * 1024 + col;
        const int b = (wid * rpw) >> 12;
        const float* mb = (const float*)(p.ws + WS_MOD) + (size_t)(k + 1) * 16 * 3072 + (size_t)b * 3072 + col;
#pragma unroll
        for (int i = 0; i < 4; ++i) {
            const f32x4 gg = *(const f32x4*)(lg + 4 * i), bb = *(const f32x4*)(lb + 4 * i);
            f32x4 sh = (f32x4){0.f, 0.f, 0.f, 0.f}, sc = (f32x4){0.f, 0.f, 0.f, 0.f};
            if (!LAST) { sh = *(const f32x4*)(mb + 4 * i); sc = *(const f32x4*)(mb + 1024 + 4 * i); }
#pragma unroll
            for (int j = 0; j < 4; ++j) { A[4 * i + j] = gg[j] * (sc[j] + 1.f); Bc[4 * i + j] = bb[j] * (sc[j] + 1.f) + sh[j]; }
        }
    }
    for (int r0 = 0; r0 < rpw; r0 += 4) {
        u32x4 ra[4], rb[4];
#pragma unroll
        for (int q = 0; q < 4; ++q) { const u16* yr = Y + (size_t)(wid * rpw + r0 + q) * 1024 + col; ra[q] = *(const u32x4*)yr; rb[q] = *(const u32x4*)(yr + 8); }
#pragma unroll
        for (int q = 0; q < 4; ++q) {
            const int row = wid * rpw + r0 + q;
            float v[16];
#pragma unroll
            for (int t = 0; t < 4; ++t) { v[2 * t] = bflo(ra[q][t]); v[2 * t + 1] = bfhi(ra[q][t]); v[8 + 2 * t] = bflo(rb[q][t]); v[8 + 2 * t + 1] = bfhi(rb[q][t]); }
            float sum = 0.f;
#pragma unroll
            for (int j = 0; j < 16; ++j) sum += v[j];
            const float mu = wave_sum(sum) * (1.f / 1024.f);
            float sq = 0.f;
#pragma unroll
            for (int j = 0; j < 16; ++j) { const float d = v[j] - mu; sq += d * d; }
            const float rstd = rsqrtf(wave_sum(sq) * (1.f / 1024.f) + 1e-5f);
            if (!LAST && lane == 0) *(f32x2_t*)(stats + (size_t)row * 2) = (f32x2_t){mu, rstd};
            float y[16];
#pragma unroll
            for (int j = 0; j < 16; ++j) y[j] = (v[j] - mu) * rstd * A[j] + Bc[j];
            if (LAST) {
#pragma unroll
                for (int i = 0; i < 4; ++i) *(f32x4*)(p.out + (size_t)row * 1024 + col + 4 * i) = (f32x4){y[4 * i], y[4 * i + 1], y[4 * i + 2], y[4 * i + 3]};
            } else {
                u16* hp = H + (size_t)row * 1024 + col;
                *(u32x4*)hp = (u32x4){cvtpk(y[0], y[1]), cvtpk(y[2], y[3]), cvtpk(y[4], y[5]), cvtpk(y[6], y[7])};
                *(u32x4*)(hp + 8) = (u32x4){cvtpk(y[8], y[9]), cvtpk(y[10], y[11]), cvtpk(y[12], y[13]), cvtpk(y[14], y[15])};
            }
        }
    }
}

DI void conv_chunk(const Params& p, u16* G, size_t idx, const u32x4& z0, const u32x4& z1, const u32x4& z2, const u32x4& bb) {
    const int col = (int)(idx & 1023);
    const float* cw = p.odd_conv_w + col;
    float o[8];
#pragma unroll
    for (int j = 0; j < 4; ++j) {
        const int c0 = 2 * j, c1 = 2 * j + 1;
        const float y0 = bflo(z2[j]) * cw[c0] + bflo(z1[j]) * cw[1024 + c0] + bflo(z0[j]) * cw[2048 + c0];
        const float y1 = bfhi(z2[j]) * cw[c1] + bfhi(z1[j]) * cw[1024 + c1] + bfhi(z0[j]) * cw[2048 + c1];
        o[c0] = bflo(bb[j]) * y0; o[c1] = bfhi(bb[j]) * y1;
    }
    *(u32x4*)(G + idx) = (u32x4){cvtpk(o[0], o[1]), cvtpk(o[2], o[3]), cvtpk(o[4], o[5]), cvtpk(o[6], o[7])};
}
DI void conv_chunk_w(u16* G, size_t idx, const u32x4& z0, const u32x4& z1, const u32x4& z2, const u32x4& bb, const float (&cw)[24]) {
    float o[8];
#pragma unroll
    for (int j = 0; j < 4; ++j) {
        const int c0 = 2 * j, c1 = 2 * j + 1;
        const float y0 = bflo(z2[j]) * cw[c0] + bflo(z1[j]) * cw[8 + c0] + bflo(z0[j]) * cw[16 + c0];
        const float y1 = bfhi(z2[j]) * cw[c1] + bfhi(z1[j]) * cw[8 + c1] + bfhi(z0[j]) * cw[16 + c1];
        o[c0] = bflo(bb[j]) * y0; o[c1] = bfhi(bb[j]) * y1;
    }
    *(u32x4*)(G + idx) = (u32x4){cvtpk(o[0], o[1]), cvtpk(o[2], o[3]), cvtpk(o[4], o[5]), cvtpk(o[6], o[7])};
}
DI void phase_conv(const Params& p) {
    const u16* B1 = (const u16*)(p.ws + WS_B1);
    const u16* CZ = (const u16*)(p.ws + WS_CZ);
    u16* G = (u16*)(p.ws + WS_MIX);
    const size_t n8 = (size_t)NT_TOK * 1024 / 8;
    const size_t stride = (size_t)VGRD * 256;
    const u32x4 zero4 = (u32x4){0u, 0u, 0u, 0u};
    size_t e = (size_t)VBLK * 256 + TIDX;
    float cwv[24];
    const bool fixedcol = ((stride * 8) & 1023) == 0;
    {
        const float* cw = p.odd_conv_w + (int)((e * 8) & 1023);
#pragma unroll
        for (int t3 = 0; t3 < 3; ++t3)
#pragma unroll
            for (int j = 0; j < 8; ++j) cwv[t3 * 8 + j] = cw[t3 * 1024 + j];
    }
    for (; fixedcol && e + 3 * stride < n8; e += 4 * stride) {
        u32x4 z0[4], z1[4], z2[4], bb[4];
#pragma unroll
        for (int k = 0; k < 4; ++k) {
            const size_t idx = (e + k * stride) * 8; const int t = (int)((idx >> 10) & 4095);
            z0[k] = *(const u32x4*)(CZ + idx);
            z1[k] = (t >= 1) ? *(const u32x4*)(CZ + idx - 1024) : zero4;
            z2[k] = (t >= 2) ? *(const u32x4*)(CZ + idx - 2048) : zero4;
            bb[k] = *(const u32x4*)(B1 + idx);
        }
#pragma unroll
        for (int k = 0; k < 4; ++k) conv_chunk_w(G, (e + k * stride) * 8, z0[k], z1[k], z2[k], bb[k], cwv);
    }
    for (; e < n8; e += stride) {
        const size_t idx = e * 8; const int t = (int)((idx >> 10) & 4095);
        const u32x4 z0 = *(const u32x4*)(CZ + idx);
        const u32x4 z1 = (t >= 1) ? *(const u32x4*)(CZ + idx - 1024) : zero4;
        const u32x4 z2 = (t >= 2) ? *(const u32x4*)(CZ + idx - 2048) : zero4;
        const u32x4 bb = *(const u32x4*)(B1 + idx);
        conv_chunk(p, G, idx, z0, z1, z2, bb);
    }
}

#define XB_TMO      128
#define XB_XCNT(j)  (256  + 64 * (j))
#define XB_XSUB(j)  (1280 + 64 * (j))
#define XB_XGEN(j)  (2304 + 64 * (j))
#define XB_TOP      3328
#define XB_TOPGEN   3392
#define XCD_BAR_WORDS 3456
#define XB_SPIN_CAP (1u << 18)
#define LAS __attribute__((address_space(3)))

__device__ __forceinline__ unsigned xb_ld(unsigned* p)              { return __hip_atomic_load(p, __ATOMIC_RELAXED, __HIP_MEMORY_SCOPE_AGENT); }
__device__ __forceinline__ unsigned xb_add(unsigned* p, unsigned v) { return __hip_atomic_fetch_add(p, v, __ATOMIC_RELAXED, __HIP_MEMORY_SCOPE_AGENT); }
__device__ __forceinline__ unsigned xb_xcc_id() { return (unsigned)__builtin_amdgcn_s_getreg((3 << 11) | 20) & 0xFu; }
#define XB_SPIN(cond, bar) do { unsigned _sp = 0; while (cond) { __builtin_amdgcn_s_sleep(1); \
    if ((++_sp & 255u) == 0u) { if (xb_ld(&(bar)[XB_TMO])) break; if (_sp > XB_SPIN_CAP) { atomicAdd(&(bar)[XB_TMO], 1u); break; } } } } while (0)

struct XcdBarrier {
    unsigned* bar; unsigned x;
    volatile LAS unsigned* st;
};

__device__ __forceinline__ XcdBarrier xcd_barrier_post(unsigned* bar, volatile LAS unsigned* st) {
    XcdBarrier b; b.bar = bar; b.x = xb_xcc_id(); b.st = st;
    if (threadIdx.x == 0) (void)xb_add(&bar[XB_XCNT(b.x)], 1u);
    return b;
}
__device__ __forceinline__ void xcd_barrier_complete(unsigned* bar, unsigned x, unsigned& nloc, unsigned& nx) {
    const unsigned G = gridDim.x * gridDim.y * gridDim.z;
    unsigned sum, cnt, mine, sp = 0u;
    for (;;) {
        sum = 0u; cnt = 0u; mine = 0u;
#pragma unroll
        for (unsigned j = 0; j < 16; ++j) { const unsigned c = xb_ld(&bar[XB_XCNT(j)]); sum += c; cnt += (c > 0u) ? 1u : 0u; mine = (j == x) ? c : mine; }
        if (sum == G) break;
        __builtin_amdgcn_s_sleep(1);
        if ((++sp & 255u) == 0u) { if (xb_ld(&bar[XB_TMO])) break; if (sp > XB_SPIN_CAP) { atomicAdd(&bar[XB_TMO], 1u); break; } }
    }
    nloc = mine > 0u ? mine : 1u; nx = cnt > 0u ? cnt : 1u;
}

__device__ __forceinline__ void xcd_barrier(const XcdBarrier& b) {
    asm volatile("s_waitcnt vmcnt(0)" ::: "memory");
    __syncthreads();
    if (threadIdx.x == 0) {
        unsigned* bar = b.bar;
        __builtin_amdgcn_s_waitcnt(0);
        unsigned nloc = b.st[0], nx = b.st[1];
        if (nloc == 0u) { xcd_barrier_complete(bar, b.x, nloc, nx); b.st[0] = nloc; b.st[1] = nx; }
        const unsigned old = xb_add(&bar[XB_XSUB(b.x)], 1u);
        const unsigned gen = old / nloc;
        if (old + 1u == (gen + 1u) * nloc) {
            __builtin_amdgcn_fence(__ATOMIC_RELEASE, "agent");
            asm volatile("s_waitcnt vmcnt(0)" ::: "memory");
            const unsigned og = xb_add(&bar[XB_TOP], 1u);
            const unsigned tg = og / nx;
            if (og + 1u == (tg + 1u) * nx) xb_add(&bar[XB_TOPGEN], 1u);
            else XB_SPIN(xb_ld(&bar[XB_TOPGEN]) == tg, bar);
            __builtin_amdgcn_fence(__ATOMIC_ACQUIRE, "agent");
            xb_add(&bar[XB_XGEN(b.x)], 1u);
            asm volatile("s_waitcnt vmcnt(0)" ::: "memory");
        } else {
            XB_SPIN(xb_ld(&bar[XB_XGEN(b.x)]) == gen, bar);
            __builtin_amdgcn_fence(__ATOMIC_ACQUIRE, "agent");
            asm volatile("s_waitcnt vmcnt(0)" ::: "memory");
        }
    }
    __syncthreads();
}

constexpr int HALF_LDS = 67584;
constexpr int LDS_BYTES = 2 * HALF_LDS + 16;
__global__ void __launch_bounds__(512, 2) fwd_megakernel(Params p) {
    extern __shared__ __attribute__((aligned(16))) unsigned char shm[];
    PG8_LAS unsigned char* glds = (PG8_LAS unsigned char*)shm;
    char* lds = (char*)shm + __builtin_amdgcn_readfirstlane((int)(threadIdx.x >> 8)) * HALF_LDS;
    cg::grid_group grid = cg::this_grid();
    volatile LAS unsigned* bst = (volatile LAS unsigned*)(glds + 2 * HALF_LDS);
    if (threadIdx.x == 0) { bst[0] = 0u; bst[1] = 0u; }
    if (blockIdx.x == 0) for (int i = threadIdx.x; i < XCD_BAR_WORDS; i += 512) ((unsigned*)(p.ws + WS_BAR))[i] = 0u;
    __syncthreads();
    unsigned char* ws = p.ws;
    const float* modp = (const float*)(ws + WS_MOD);
    u16* YB = (u16*)(ws + WS_XY);
    const float* stp = (const float*)(ws + WS_STATS);
    const u16* H = (const u16*)(ws + WS_H);
    phase0<0>(p, lds);
    grid.sync();
    const XcdBarrier xb = xcd_barrier_post((unsigned*)(p.ws + WS_BAR), bst);
    phase0<1>(p, lds);
    phase_mod_x(p);
    xcd_barrier(xb);
    run_gemm(glds, H, (const u16*)(ws + WS_WT_IN0), NT_TOK, 1792, 1024, EpiRowBf16{(u16*)(ws + WS_PR), LDP});
    run_gemm(glds, (const u16*)(ws + WS_WT_IN0) + (size_t)1792 * 1024, H, NVT, NT_TOK, 1024, EpiVT{(u16*)(ws + WS_VT)});
    xcd_barrier(xb);
    if (VBLK < 128) {
        compress_item(p, VBLK, lds);
        for (int it = VBLK; it < 512; it += 128) gmlp_item(p, it, lds);
    } else {
        for (int it = 512 + VBLK - 128; it < 4096 + 2048; it += VGRD - 128) {
            if (it < 4096) gmlp_item(p, it, lds); else repack_item(p, it - 4096);
        }
    }
    xcd_barrier(xb);
    for (int it0 = 0, rnd = 0; it0 < 4096; it0 += VGRD, ++rnd) {
        const int it = it0 + ((rnd & 1) ? (VGRD - 1 - VBLK) ^ 1 : VBLK);
        if (it < 4096) nsa_item(p, it, lds);
        __syncthreads();
    }
    xcd_barrier(xb);
    run_gemm(glds, (const u16*)(ws + WS_MIX), (const u16*)(ws + WS_WT_OUT0), NT_TOK, 1024, 1024, EpiRes<true>{p.x, YB, stp, p.ln_g, p.ln_b, modp + 0 * 16 * 3072 + 2048});
    xcd_barrier(xb);
    phase_ln<false>(p, 0);
    xcd_barrier(xb);
    run_gemm(glds, H, (const u16*)(ws + WS_WT_FI0), NT_TOK, 2 * FF, 1024, EpiSwiglu{(u16*)(ws + WS_ACT)});
    xcd_barrier(xb);
    run_gemm(glds, (const u16*)(ws + WS_ACT), (const u16*)(ws + WS_WT_FO0), NT_TOK, 1024, FF, EpiRes<false>{p.x, YB, stp, p.ln_g + 0 * 1024, p.ln_b + 0 * 1024, modp + 1 * 16 * 3072 + 2048});
    xcd_barrier(xb);
    phase_ln<false>(p, 1);
    xcd_barrier(xb);
    run_gemm(glds, H, (const u16*)(ws + WS_WT_IN1), NT_TOK, 3072, 1024, EpiIn1{(u16*)(ws + WS_B1), (u16*)(ws + WS_CZ)});
    xcd_barrier(xb);
    phase_conv(p);
    xcd_barrier(xb);
    run_gemm(glds, (const u16*)(ws + WS_MIX), (const u16*)(ws + WS_WT_OUT1), NT_TOK, 1024, 1024, EpiRes<false>{p.x, YB, stp, p.ln_g + 1 * 1024, p.ln_b + 1 * 1024, modp + 2 * 16 * 3072 + 2048});
    xcd_barrier(xb);
    phase_ln<false>(p, 2);
    xcd_barrier(xb);
    run_gemm(glds, H, (const u16*)(ws + WS_WT_FI1), NT_TOK, 2 * FF, 1024, EpiSwiglu{(u16*)(ws + WS_ACT)});
    xcd_barrier(xb);
    run_gemm(glds, (const u16*)(ws + WS_ACT), (const u16*)(ws + WS_WT_FO1), NT_TOK, 1024, FF, EpiRes<false>{p.x, YB, stp, p.ln_g + 2 * 1024, p.ln_b + 2 * 1024, modp + 3 * 16 * 3072 + 2048});
    xcd_barrier(xb);
    phase_ln<true>(p, 3);
}

extern "C" void kernel_launch(void* const* d_in, const int* in_sizes, int n_in, void* d_out, int out_size, void* d_ws, size_t ws_size,
                              hipStream_t stream) {
    static int grid_blocks = 0;
    if (!grid_blocks) {
        int dev = 0, cus = 0, per_cu = 0;
        (void)hipGetDevice(&dev);
        (void)hipDeviceGetAttribute(&cus, hipDeviceAttributeMultiprocessorCount, dev);
        (void)hipFuncSetAttribute((const void*)fwd_megakernel, hipFuncAttributeMaxDynamicSharedMemorySize, LDS_BYTES);
        (void)hipOccupancyMaxActiveBlocksPerMultiprocessor(&per_cu, fwd_megakernel, 512, LDS_BYTES);
        if (per_cu < 1) fprintf(stderr, "kernel_launch: occupancy query says %d blocks/CU\n", per_cu);
        grid_blocks = cus;
        if (ws_size < WS_END) fprintf(stderr, "kernel_launch: workspace too small: %zu < %zu\n", ws_size, (size_t)WS_END);
    }
    Params p{};
    p.x = (const float*)d_in[0]; p.c = (const float*)d_in[1]; p.ada_w = (const float*)d_in[2]; p.ada_b = (const float*)d_in[3];
    p.ln_g = (const float*)d_in[4]; p.ln_b = (const float*)d_in[5]; p.even_w_in = (const float*)d_in[6]; p.cmp_pos = (const float*)d_in[7];
    p.cmp_w1 = (const float*)d_in[8]; p.cmp_w2 = (const float*)d_in[9]; p.gmlp_norm_g = (const float*)d_in[10]; p.gmlp_ws = (const float*)d_in[11];
    p.gmlp_bs = (const float*)d_in[12]; p.even_w_out = (const float*)d_in[13]; p.odd_w_in = (const float*)d_in[14]; p.odd_conv_w = (const float*)d_in[15];
    p.odd_w_out = (const float*)d_in[16]; p.ffn_w_in = (const float*)d_in[17]; p.ffn_w_out = (const float*)d_in[18];
    p.out = (float*)d_out; p.ws = (unsigned char*)d_ws;
    void* args[] = {&p};
    hipError_t e = hipLaunchCooperativeKernel((void*)fwd_megakernel, dim3(grid_blocks), dim3(512), args, LDS_BYTES, stream);
    if (e != hipSuccess) fprintf(stderr, "cooperative launch failed: %s (grid %d)\n", hipGetErrorString(e), grid_blocks);
}
```

```cpp
#include <hip/hip_runtime.h>
#include <hip/hip_cooperative_groups.h>
#include <cstdio>
namespace cg = cooperative_groups;

#define DI __device__ __forceinline__
#define TIDX (threadIdx.x & 255)
#define VBLK ((int)(blockIdx.x * 2) + __builtin_amdgcn_readfirstlane((int)(threadIdx.x >> 8)))
#define VGRD (gridDim.x * 2)
typedef unsigned short u16;
typedef short bf16x8 __attribute__((ext_vector_type(8)));
typedef float f32x16 __attribute__((ext_vector_type(16)));
typedef float f32x4 __attribute__((ext_vector_type(4)));
typedef float f32x2_t __attribute__((ext_vector_type(2)));
typedef __bf16 bf16x2_t __attribute__((ext_vector_type(2)));
typedef unsigned u32x4 __attribute__((ext_vector_type(4)));
typedef unsigned u32x2 __attribute__((ext_vector_type(2)));
#define MFMA(a, b, c) __builtin_amdgcn_mfma_f32_32x32x16_bf16((a), (b), (c), 0, 0, 0)

constexpr int NT_TOK = 65536;
constexpr int SEQ = 4096;
constexpr int DM = 1024;
constexpr int FF = 2816;
constexpr int LDP = 1792;
constexpr int NVT = 768;
constexpr float ALPHA_RES = 1.4142135623730951f;

constexpr size_t AL(size_t x) { return (x + 255) & ~(size_t)255; }
constexpr size_t WS_WT_IN0 = 0;
constexpr size_t WS_WT_OUT0 = WS_WT_IN0 + AL((size_t)2560 * 1024 * 2);
constexpr size_t WS_WT_FI0 = WS_WT_OUT0 + AL((size_t)1024 * 1024 * 2);
constexpr size_t WS_WT_FI1 = WS_WT_FI0 + AL((size_t)5632 * 1024 * 2);
constexpr size_t WS_WT_FO0 = WS_WT_FI1 + AL((size_t)5632 * 1024 * 2);
constexpr size_t WS_WT_FO1 = WS_WT_FO0 + AL((size_t)1024 * 2816 * 2);
constexpr size_t WS_WT_IN1 = WS_WT_FO1 + AL((size_t)1024 * 2816 * 2);
constexpr size_t WS_WT_OUT1 = WS_WT_IN1 + AL((size_t)3072 * 1024 * 2);
constexpr size_t WS_W1T = WS_WT_OUT1 + AL((size_t)1024 * 1024 * 2);
constexpr size_t WS_W2T = WS_W1T + AL((size_t)2 * 128 * 2048 * 2);
constexpr size_t WS_TRIL = WS_W2T + AL((size_t)2 * 64 * 128 * 2);
constexpr size_t WS_MOD = WS_TRIL + AL((size_t)8 * 128 * 128 * 2);
constexpr size_t WS_B1P = WS_MOD + AL((size_t)4 * 16 * 3072 * 4);
constexpr size_t WS_KCMP = WS_B1P + AL((size_t)2 * 16 * 128 * 4);
constexpr size_t WS_VCMPT = WS_KCMP + AL((size_t)32 * 256 * 64 * 2);
constexpr size_t WS_XY = WS_VCMPT + AL((size_t)32 * 64 * 256 * 2);
constexpr size_t WS_STATS = WS_XY + AL((size_t)NT_TOK * 1024 * 2);
constexpr size_t WS_H = WS_XY + AL((size_t)NT_TOK * 1024 * 4);
constexpr size_t WS_MIX = WS_H + AL((size_t)NT_TOK * 1024 * 2);
constexpr size_t WS_P = WS_MIX + AL((size_t)NT_TOK * 1024 * 2);
constexpr size_t WS_PR = WS_P;
constexpr size_t WS_VT = WS_PR + AL((size_t)(NT_TOK + 16) * LDP * 2);
constexpr size_t WS_ACT = WS_P;
constexpr size_t WS_B1 = WS_P;
constexpr size_t WS_CZ = WS_B1 + AL((size_t)NT_TOK * 1024 * 2);
constexpr size_t WS_PEND = WS_P + AL((size_t)NT_TOK * 2816 * 2);
constexpr size_t FRAG_BYTES = (size_t)32 * 128 * 4 * 64 * 8 * 2;
constexpr size_t WS_KSF = WS_PEND;
constexpr size_t WS_KWF = WS_KSF + FRAG_BYTES;
constexpr size_t WS_VSF = WS_KWF + FRAG_BYTES;
constexpr size_t WS_VWF = WS_VSF + FRAG_BYTES;
constexpr size_t WS_BAR = WS_VWF + FRAG_BYTES;
constexpr size_t WS_END = WS_BAR + 16384;

struct Params {
    const float* x; const float* c; const float* ada_w; const float* ada_b; const float* ln_g; const float* ln_b;
    const float* even_w_in; const float* cmp_pos; const float* cmp_w1; const float* cmp_w2;
    const float* gmlp_norm_g; const float* gmlp_ws; const float* gmlp_bs; const float* even_w_out;
    const float* odd_w_in; const float* odd_conv_w; const float* odd_w_out; const float* ffn_w_in; const float* ffn_w_out;
    float* out; unsigned char* ws;
};

DI unsigned cvtpk(float lo, float hi) { f32x2_t v = {lo, hi}; bf16x2_t b = __builtin_convertvector(v, bf16x2_t); return __builtin_bit_cast(unsigned, b); }
DI float bf2f(u16 v) { return __uint_as_float(((unsigned)v) << 16); }
DI float bflo(unsigned v) { return __uint_as_float(v << 16); }
DI float bfhi(unsigned v) { return __uint_as_float(v & 0xffff0000u); }
DI int crow(int i, int h) { return (i & 3) + 8 * (i >> 2) + 4 * h; }
DI float fexp2(float x) { return __builtin_amdgcn_exp2f(x); }
DI float sigmoidf_(float x) { return __builtin_amdgcn_rcpf(1.f + fexp2(-1.4426950408889634f * x)); }
DI float siluf_(float x) { return x * __builtin_amdgcn_rcpf(1.f + fexp2(-1.4426950408889634f * x)); }
DI float geluf_(float x) {
    const float u = 1.5957691216057308f * (x + 0.044715f * x * x * x);
    return x * __builtin_amdgcn_rcpf(1.f + fexp2(-1.4426950408889634f * u));
}
DI float wave_sum(float v) {
#pragma unroll
    for (int o = 32; o >= 1; o >>= 1) v += __shfl_xor(v, o);
    return v;
}

template <bool TR>
DI void gemm_main(const u16* __restrict__ A, long lda, long akc, const u16* __restrict__ Bt, long ldb, int nk,
                  char* lds, f32x16 (&acc)[2][2]) {
    const int tid = TIDX, lane = tid & 63, w = tid >> 6, wm = w >> 1, wn = w & 1, r = lane & 31, h = lane >> 5;
    const int lrow = tid >> 3, lc = tid & 7;
    const int soff = lrow * 128 + ((lc ^ ((lrow >> 1) & 7)) << 4);
    const u16* ag = A + (long)lrow * lda + lc * 8;
    const u16* bg = Bt + (long)lrow * ldb + lc * 8;
    u32x4 ra[4], rb[4];
#pragma unroll
    for (int i = 0; i < 4; ++i) {
        ra[i] = *(const u32x4*)(ag + (long)(32 * i) * lda);
        rb[i] = *(const u32x4*)(bg + (long)(32 * i) * ldb);
    }
#pragma unroll
    for (int i = 0; i < 4; ++i) {
        *(u32x4*)(lds + soff + i * 4096) = ra[i];
        *(u32x4*)(lds + 16384 + soff + i * 4096) = rb[i];
    }
    __syncthreads();
    const int sw = (r >> 1) & 7;
    const int arow = (wm * 64 + r) * 128, brow = (wn * 64 + r) * 128;
    for (int kt = 0; kt < nk; ++kt) {
        char* cur = lds + (kt & 1) * 32768;
        char* nxt = lds + ((kt + 1) & 1) * 32768;
        const bool more = (kt + 1 < nk);
        if (more) {
            const u16* ag2 = ag + (long)(kt + 1) * akc;
            const u16* bg2 = bg + (long)(kt + 1) * 64;
#pragma unroll
            for (int i = 0; i < 4; ++i) {
                ra[i] = *(const u32x4*)(ag2 + (long)(32 * i) * lda);
                rb[i] = *(const u32x4*)(bg2 + (long)(32 * i) * ldb);
            }
        }
#pragma unroll
        for (int ks = 0; ks < 4; ++ks) {
            const int co = ((ks * 2 + h) ^ sw) << 4;
            bf16x8 af[2], bfr[2];
#pragma unroll
            for (int i = 0; i < 2; ++i) {
                af[i] = *(const bf16x8*)(cur + arow + i * 4096 + co);
                bfr[i] = *(const bf16x8*)(cur + 16384 + brow + i * 4096 + co);
            }
#pragma unroll
            for (int mi = 0; mi < 2; ++mi)
#pragma unroll
                for (int ni = 0; ni < 2; ++ni)
                    acc[mi][ni] = TR ? MFMA(bfr[ni], af[mi], acc[mi][ni]) : MFMA(af[mi], bfr[ni], acc[mi][ni]);
        }
        if (more) {
#pragma unroll
            for (int i = 0; i < 4; ++i) {
                *(u32x4*)(nxt + soff + i * 4096) = ra[i];
                *(u32x4*)(nxt + 16384 + soff + i * 4096) = rb[i];
            }
        }
        __syncthreads();
    }
}

template <bool TR>
DI void gemm_main_pf2(const u16* __restrict__ A, long lda, long akc, const u16* __restrict__ Bt, long ldb, int nk,
                      char* lds, f32x16 (&acc)[2][2]) {
    const int tid = TIDX, lane = tid & 63, w = tid >> 6, wm = w >> 1, wn = w & 1, r = lane & 31, h = lane >> 5;
    const int lrow = tid >> 3, lc = tid & 7;
    const int soff = lrow * 128 + ((lc ^ ((lrow >> 1) & 7)) << 4);
    const u16* ag = A + (long)lrow * lda + lc * 8;
    const u16* bg = Bt + (long)lrow * ldb + lc * 8;
    u32x4 ra0[4], rb0[4], ra1[4], rb1[4];
    auto gload = [&](u32x4 (&ra)[4], u32x4 (&rb)[4], int kt) {
        const u16* ag2 = ag + (long)kt * akc; const u16* bg2 = bg + (long)kt * 64;
#pragma unroll
        for (int i = 0; i < 4; ++i) { ra[i] = *(const u32x4*)(ag2 + (long)(32 * i) * lda); rb[i] = *(const u32x4*)(bg2 + (long)(32 * i) * ldb); }
    };
    auto lstore = [&](const u32x4 (&ra)[4], const u32x4 (&rb)[4], char* buf) {
#pragma unroll
        for (int i = 0; i < 4; ++i) { *(u32x4*)(buf + soff + i * 4096) = ra[i]; *(u32x4*)(buf + 16384 + soff + i * 4096) = rb[i]; }
    };
    const int sw = (r >> 1) & 7;
    const int arow = (wm * 64 + r) * 128, brow = (wn * 64 + r) * 128;
    auto compute = [&](const char* cur) {
#pragma unroll
        for (int ks = 0; ks < 4; ++ks) {
            const int co = ((ks * 2 + h) ^ sw) << 4;
            bf16x8 af[2], bfr[2];
#pragma unroll
            for (int i = 0; i < 2; ++i) { af[i] = *(const bf16x8*)(cur + arow + i * 4096 + co); bfr[i] = *(const bf16x8*)(cur + 16384 + brow + i * 4096 + co); }
#pragma unroll
            for (int mi = 0; mi < 2; ++mi)
#pragma unroll
                for (int ni = 0; ni < 2; ++ni)
                    acc[mi][ni] = TR ? MFMA(bfr[ni], af[mi], acc[mi][ni]) : MFMA(af[mi], bfr[ni], acc[mi][ni]);
        }
    };
    gload(ra0, rb0, 0);
    gload(ra1, rb1, 1);
    lstore(ra0, rb0, lds);
    __syncthreads();
#pragma unroll 1
    for (int kt = 0; kt < nk; kt += 2) {
        gload(ra0, rb0, kt + 2 < nk ? kt + 2 : nk - 1);
        compute(lds);
        lstore(ra1, rb1, lds + 32768);
        __syncthreads();
        gload(ra1, rb1, kt + 3 < nk ? kt + 3 : nk - 1);
        compute(lds + 32768);
        lstore(ra0, rb0, lds);
        __syncthreads();
    }
}

DI void zero_acc(f32x16 (&acc)[2][2]) {
#pragma unroll
    for (int a = 0; a < 2; ++a)
#pragma unroll
        for (int b = 0; b < 2; ++b)
#pragma unroll
            for (int i = 0; i < 16; ++i) acc[a][b][i] = 0.f;
}

DI int src_col(int kind, int p) {
    if (kind == 0) return p;
    if (kind == 1) {
        if (p < 896) return p;
        if (p < 1024) return p + 128;
        if (p < 1536) return p - 1024 + 1304;
        if (p < 1560) return p - 1536 + 1280;
        if (p < 1792) return -1;
        if (p < 1920) return p - 1792 + 896;
        if (p < 2048) return p - 1920 + 1152;
        return p - 2048 + 1816;
    }
    if (kind == 2) {
        const int tile = p >> 8, bj = (p >> 7) & 1, i = p & 127;
        return (bj ? FF : 0) + tile * 128 + i;
    }
    if (p < 1024) return p;
    const int pp = p - 1024, tile = pp >> 8, bj = (pp >> 7) & 1, i = pp & 127;
    return 1024 + (bj ? 1024 : 0) + tile * 128 + i;
}

struct TrJob { const float* src; u16* dst; int K, ldn, kind, pt, ktile; };
DI void tr_load(const TrJob& j, float (&v)[16], int tid) {
    const int nl = tid & 63, kq = tid >> 6;
    const int sc = src_col(j.kind, j.pt * 64 + nl);
    const float* sp = j.src + (long)(j.ktile * 64 + kq) * j.ldn + (sc >= 0 ? sc : 0);
#pragma unroll
    for (int i = 0; i < 16; ++i) v[i] = (sc >= 0) ? sp[(long)(4 * i) * j.ldn] : 0.f;
}
DI void tr_to_lds(const float (&v)[16], char* lds, int tid) {
    float* tile = (float*)lds;
    const int nl = tid & 63, kq = tid >> 6;
#pragma unroll
    for (int i = 0; i < 16; ++i) tile[(kq + 4 * i) * 65 + nl] = v[i];
}
DI void tr_store(const TrJob& j, char* lds, int tid) {
    const float* tile = (const float*)lds;
    const int n = tid >> 2, part = tid & 3;
    unsigned pk[8];
#pragma unroll
    for (int q = 0; q < 8; ++q) pk[q] = cvtpk(tile[(part * 16 + 2 * q) * 65 + n], tile[(part * 16 + 2 * q + 1) * 65 + n]);
    u16* dp = j.dst + (long)(j.pt * 64 + n) * j.K + j.ktile * 64 + part * 16;
    *(u32x4*)dp = (u32x4){pk[0], pk[1], pk[2], pk[3]};
    *(u32x4*)(dp + 8) = (u32x4){pk[4], pk[5], pk[6], pk[7]};
}

template <int PART>
DI void phase0(const Params& p, char* lds) {
    const int tid = TIDX;
    unsigned char* ws = p.ws;
    constexpr int N_ADA = 384, N_B1 = 32, N_TRIL = 64;
    constexpr int NJ = 12;
    const int jitems[NJ] = {40 * 16, 16 * 16, 88 * 16, 88 * 16, 16 * 44, 16 * 44, 48 * 16, 16 * 16, 2 * 32, 2 * 32, 1 * 2, 1 * 2};
    int total = N_ADA + N_B1 + N_TRIL;
#pragma unroll
    for (int j = 0; j < NJ; ++j) total += jitems[j];
    for (int it = VBLK; PART == 0 && it < N_ADA + N_B1 + N_TRIL; it += VGRD) {
        if (it < N_ADA) {
            const int ls = it / 96, cgp = it % 96;
            float* sc = (float*)lds;
#pragma unroll 16
            for (int e = tid; e < 16384; e += 256) { const int b = e >> 10, k = e & 1023; sc[k * 16 + b] = siluf_(p.c[e]); }
            __syncthreads();
            const int cq = tid & 7, kg = tid >> 3;
            const float* W = p.ada_w + (size_t)ls * 1024 * 3072 + cgp * 32 + cq * 4;
            f32x4 acc[16];
#pragma unroll
            for (int b = 0; b < 16; ++b) acc[b] = (f32x4){0.f, 0.f, 0.f, 0.f};
#pragma unroll 8
            for (int k = kg * 32; k < kg * 32 + 32; ++k) {
                const f32x4 wv = *(const f32x4*)(W + (size_t)k * 3072);
                const f32x4* s4 = (const f32x4*)(sc + k * 16);
#pragma unroll
                for (int q = 0; q < 4; ++q) { const f32x4 sv = s4[q]; acc[4 * q] += wv * sv[0]; acc[4 * q + 1] += wv * sv[1]; acc[4 * q + 2] += wv * sv[2]; acc[4 * q + 3] += wv * sv[3]; }
            }
            __syncthreads();
            float* red = (float*)lds;
#pragma unroll
            for (int b = 0; b < 16; ++b) *(f32x4*)(red + (kg * 16 + b) * 32 + cq * 4) = acc[b];
            __syncthreads();
            float* mod = (float*)(ws + WS_MOD);
            for (int e = tid; e < 512; e += 256) {
                const int b = e >> 5, cl = e & 31;
                float v = 0.f;
#pragma unroll 8
                for (int g2 = 0; g2 < 32; ++g2) v += red[(g2 * 16 + b) * 32 + cl];
                mod[((size_t)ls * 16 + b) * 3072 + cgp * 32 + cl] = v + p.ada_b[ls * 3072 + cgp * 32 + cl];
            }
            __syncthreads();
            continue;
        }
        int i2 = it - N_ADA;
        if (i2 < N_B1) {
            const int wh = i2 >> 4, ch = i2 & 15;
            const int col = tid & 127, half = tid >> 7;
            const float* pos = p.cmp_pos + wh * 2048 + ch * 128 + half * 64;
            const float* w1 = p.cmp_w1 + ((size_t)wh * 2048 + ch * 128 + half * 64) * 128 + col;
            float a = 0.f;
#pragma unroll 8
            for (int k = 0; k < 64; ++k) a += pos[k] * w1[(size_t)k * 128];
            float* red = (float*)lds;
            red[tid] = a;
            __syncthreads();
            if (tid < 128) ((float*)(ws + WS_B1P))[(wh * 16 + ch) * 128 + tid] = red[tid] + red[tid + 128];
            __syncthreads();
            continue;
        }
        i2 -= N_B1;
        if (i2 < N_TRIL) {
            u16* dst = (u16*)(ws + WS_TRIL);
            const int e0 = (i2 * 256 + tid) * 8;
            const int s0 = e0 & 127, t = (e0 >> 7) & 127;
            const f32x4 a = *(const f32x4*)(p.gmlp_ws + e0), b = *(const f32x4*)(p.gmlp_ws + e0 + 4);
            float v[8] = {a[0], a[1], a[2], a[3], b[0], b[1], b[2], b[3]};
#pragma unroll
            for (int j = 0; j < 8; ++j) if (s0 + j > t) v[j] = 0.f;
            *(u32x4*)(dst + e0) = (u32x4){cvtpk(v[0], v[1]), cvtpk(v[2], v[3]), cvtpk(v[4], v[5]), cvtpk(v[6], v[7])};
            continue;
        }
    }
    auto decode = [&](int i2) {
        int job = 0;
#pragma unroll
        for (int j = 0; j < NJ; ++j) { if (job == j && i2 >= jitems[j]) { i2 -= jitems[j]; job = j + 1; } }
        const float* src; u16* dst; int K, ldn, kind;
        switch (job) {
            case 0: src = p.even_w_in; dst = (u16*)(ws + WS_WT_IN0); K = 1024; ldn = 2328; kind = 1; break;
            case 1: src = p.even_w_out; dst = (u16*)(ws + WS_WT_OUT0); K = 1024; ldn = 1024; kind = 0; break;
            case 2: src = p.ffn_w_in; dst = (u16*)(ws + WS_WT_FI0); K = 1024; ldn = 5632; kind = 2; break;
            case 3: src = p.ffn_w_in + (size_t)1024 * 5632; dst = (u16*)(ws + WS_WT_FI1); K = 1024; ldn = 5632; kind = 2; break;
            case 4: src = p.ffn_w_out; dst = (u16*)(ws + WS_WT_FO0); K = 2816; ldn = 1024; kind = 0; break;
            case 5: src = p.ffn_w_out + (size_t)2816 * 1024; dst = (u16*)(ws + WS_WT_FO1); K = 2816; ldn = 1024; kind = 0; break;
            case 6: src = p.odd_w_in; dst = (u16*)(ws + WS_WT_IN1); K = 1024; ldn = 3072; kind = 3; break;
            case 7: src = p.odd_w_out; dst = (u16*)(ws + WS_WT_OUT1); K = 1024; ldn = 1024; kind = 0; break;
            case 8: src = p.cmp_w1; dst = (u16*)(ws + WS_W1T); K = 2048; ldn = 128; kind = 0; break;
            case 9: src = p.cmp_w1 + (size_t)2048 * 128; dst = (u16*)(ws + WS_W1T) + (size_t)128 * 2048; K = 2048; ldn = 128; kind = 0; break;
            case 10: src = p.cmp_w2; dst = (u16*)(ws + WS_W2T); K = 128; ldn = 64; kind = 0; break;
            default: src = p.cmp_w2 + 128 * 64; dst = (u16*)(ws + WS_W2T) + 64 * 128; K = 128; ldn = 64; kind = 0; break;
        }
        const int nkt = K / 64, npt = jitems[job] / nkt;
        return TrJob{src, dst, K, ldn, kind, i2 % npt, i2 / npt};
    };
    const int ntr_all = total - (N_ADA + N_B1 + N_TRIL);
    constexpr int NPRE = N_ADA + N_B1 + N_TRIL, NA = (512 - NPRE) * 2;
    int it, ntr, tstride;
    if (PART == 0) { it = VBLK - NPRE; if (it < 0) it = NA; ntr = NA; tstride = VGRD - NPRE; }
    else { it = NA + VBLK; ntr = ntr_all; tstride = VGRD; }
    float v[16];
    TrJob cur{};
    if (it < ntr) { cur = decode(it); tr_load(cur, v, tid); }
    while (it < ntr) {
        tr_to_lds(v, lds, tid);
        __syncthreads();
        const int nit = it + tstride;
        TrJob nxt{};
        nxt = decode(nit < ntr ? nit : it); tr_load(nxt, v, tid);
        tr_store(cur, lds, tid);
        __syncthreads();
        cur = nxt; it = nit;
    }
}

DI void phase_mod_x(const Params& p) {
    const float* mod = (const float*)(p.ws + WS_MOD);
    u16* H = (u16*)(p.ws + WS_H);
    const size_t n8 = (size_t)NT_TOK * 1024 / 8;
    const size_t stride = (size_t)VGRD * 256;
    size_t e = (size_t)VBLK * 256 + TIDX;
    for (; e + 3 * stride < n8; e += 4 * stride) {
        f32x4 x0[4], x1[4];
#pragma unroll
        for (int k = 0; k < 4; ++k) { const size_t idx = (e + k * stride) * 8; x0[k] = *(const f32x4*)(p.x + idx); x1[k] = *(const f32x4*)(p.x + idx + 4); }
        f32x4 sh0[4], sh1[4], sc0[4], sc1[4];
#pragma unroll
        for (int k = 0; k < 4; ++k) {
            const size_t idx = (e + k * stride) * 8; const int col = (int)(idx & 1023); const int b = (int)(idx >> 22);
            const float* mb = mod + (size_t)b * 3072;
            sh0[k] = *(const f32x4*)(mb + col); sh1[k] = *(const f32x4*)(mb + col + 4);
            sc0[k] = *(const f32x4*)(mb + 1024 + col); sc1[k] = *(const f32x4*)(mb + 1024 + col + 4);
        }
#pragma unroll
        for (int k = 0; k < 4; ++k) {
            const size_t idx = (e + k * stride) * 8;
            const f32x4 h0 = x0[k] * (sc0[k] + 1.f) + sh0[k], h1 = x1[k] * (sc1[k] + 1.f) + sh1[k];
            *(u32x4*)(H + idx) = (u32x4){cvtpk(h0[0], h0[1]), cvtpk(h0[2], h0[3]), cvtpk(h1[0], h1[1]), cvtpk(h1[2], h1[3])};
        }
    }
    for (; e < n8; e += stride) {
        const size_t idx = e * 8; const int col = (int)(idx & 1023); const int b = (int)(idx >> 22);
        const float* mb = mod + (size_t)b * 3072;
        const f32x4 x0 = *(const f32x4*)(p.x + idx), x1 = *(const f32x4*)(p.x + idx + 4);
        const f32x4 sh0 = *(const f32x4*)(mb + col), sh1 = *(const f32x4*)(mb + col + 4);
        const f32x4 sc0 = *(const f32x4*)(mb + 1024 + col), sc1 = *(const f32x4*)(mb + 1024 + col + 4);
        const f32x4 h0 = x0 * (sc0 + 1.f) + sh0, h1 = x1 * (sc1 + 1.f) + sh1;
        *(u32x4*)(H + idx) = (u32x4){cvtpk(h0[0], h0[1]), cvtpk(h0[2], h0[3]), cvtpk(h1[0], h1[1]), cvtpk(h1[2], h1[3])};
    }
}

namespace pg8 {
#define PG8_LAS __attribute__((address_space(3)))
typedef unsigned short bf16_t;
typedef short bf16x8 __attribute__((ext_vector_type(8)));
typedef float f32x4 __attribute__((ext_vector_type(4)));
typedef unsigned u32x4 __attribute__((ext_vector_type(4)));
constexpr int BM = 256, BK = 64, HALF = 128, HTB = HALF * BK * 2  , STAGE_BYTES = 8 * HTB, NXCD = 8, WGM = 8;

__host__ __device__ __forceinline__ int lds_byte(int r, int c) { const int st = (r >> 4) * 2 + (c >> 5), rr = r & 15, cc = c & 31, ob = rr * 64 + cc * 2; return st * 1024 + (ob ^ (((ob >> 9) & 1) << 5)); }
__host__ __device__ __forceinline__ void stage_rc(int b, int& R, int& C) { const int st = b / 1024, sb = b % 1024, swz = sb ^ (((sb >> 9) & 1) << 5); R = (st >> 1) * 16 + swz / 64; C = (st & 1) * 32 + (swz % 64) / 2; }
__host__ __device__ __forceinline__ int perm32(int rho) { const int n = rho >> 4, i = rho & 15; return 8 * (i >> 2) + 4 * n + (i & 3); }

struct Unit { int pm, pn; };
struct Gemm { const bf16_t* A; const bf16_t* Bt; int M, N, K; };

struct StaticOrder {
    int nM, nN, nwg, G, c;
    __host__ __device__ void init(int M, int N, int G_, int c_) { nM = M / BM; nN = N / BM; nwg = nM * nN; G = G_; c = c_; }
    __host__ __device__ bool next(int i, Unit& u) const {
        const long L = (long)i * G + c; if (L >= nwg) return false;
        int wgid = (int)L; { const int q = nwg / NXCD, r = nwg % NXCD, xcd = wgid % NXCD, off = wgid / NXCD; wgid = (xcd < r ? xcd * (q + 1) : r * (q + 1) + (xcd - r) * q) + off; }
        const int nig = WGM * nN, gid = wgid / nig, fm = gid * WGM, gsz = (nM - fm) < WGM ? (nM - fm) : WGM;
        u.pm = fm + ((wgid % nig) % gsz); u.pn = (wgid % nig) / gsz; return true;
    }
    __device__ __forceinline__ void a_ready(const Unit&) const {}
    __device__ __forceinline__ void done(const Unit&) const {}
};
template <class Epi, class Sched, bool STAMP = false>
__device__ __forceinline__ void gemm_phase(PG8_LAS unsigned char* lds, const Gemm g, const Sched& S, const Epi& E, unsigned long long* stamps) {
    int tid = threadIdx.x;
    asm volatile("" : "+v"(tid));
    const int wid = __builtin_amdgcn_readfirstlane(tid >> 6), lane = tid & 63, wr = wid >> 2, wc = wid & 3, fr = lane & 15, fq = lane >> 4;
    const int K = g.K, nt = K / BK;
    int ts_lo = 0, ts_hi = 0, nts = 0; const unsigned long long rt_entry = STAMP ? (unsigned long long)wall_clock64() : 0ull;
#define PG8_STAMP() do { if (STAMP && wid == 0 && nts < 64) { const unsigned long long _c = (unsigned long long)clock64(); \
        ts_lo = (lane == nts) ? (int)(unsigned)_c : ts_lo; ts_hi = (lane == nts) ? (int)(unsigned)(_c >> 32) : ts_hi; ++nts; } } while (0)
    PG8_STAMP();
    unsigned voffA[2], voffB[2];
#pragma unroll
    for (int i = 0; i < 2; ++i) { int R, C; stage_rc(tid * 16 + i * 8192, R, C); const int Rb = Epi::PERM ? ((R & ~31) + perm32(R & 31)) : R;
        voffA[i] = (unsigned)(R * K + C) * 2u; voffB[i] = (unsigned)(Rb * K + C) * 2u; }
    const size_t kstep = (size_t)(BK * 2);
    const size_t hstep = (size_t)HALF * K * 2;
    const size_t tstep = 2 * hstep;
    const unsigned ldsw = (unsigned)wid * 1024u;
    const int aoff = lds_byte(wr * 64 + fr, fq * 8), boff = lds_byte(wc * 32 + fr, fq * 8);
#define PG8_SA(b, h) (((b) * 2 + (h)) * HTB)
#define PG8_SB(b, h) ((4 + (b) * 2 + (h)) * HTB)
#define PG8_STAGE(bufoff, gbase, voff) do { _Pragma("unroll") for (int _i = 0; _i < 2; ++_i) \
        __builtin_amdgcn_global_load_lds((const unsigned*)((const char*)(gbase) + (voff)[_i]), (PG8_LAS unsigned*)(lds + (bufoff) + ldsw + _i * 8192), 16, 0, 0); } while (0)
#define PG8_LDA(dst, b, h) do { _Pragma("unroll") for (int m = 0; m < 4; ++m) _Pragma("unroll") for (int k = 0; k < 2; ++k) dst[m][k] = *(const PG8_LAS bf16x8*)(lds + PG8_SA(b, h) + aoff + m * 2048 + k * 1024); } while (0)
#define PG8_LDB(dst, b, h) do { _Pragma("unroll") for (int n = 0; n < 2; ++n) _Pragma("unroll") for (int k = 0; k < 2; ++k) dst[n][k] = *(const PG8_LAS bf16x8*)(lds + PG8_SB(b, h) + boff + n * 2048 + k * 1024); } while (0)
#define PG8_MMA(ai, bj, At, Bt) do { __builtin_amdgcn_s_setprio(1); _Pragma("unroll") for (int m = 0; m < 4; ++m) _Pragma("unroll") for (int n = 0; n < 2; ++n) _Pragma("unroll") for (int k = 0; k < 2; ++k) \
        acc[ai][bj][m][n] = __builtin_amdgcn_mfma_f32_16x16x32_bf16(Bt[n][k], At[m][k], acc[ai][bj][m][n], 0, 0, 0); __builtin_amdgcn_s_setprio(0); } while (0)
#define PG8_WAIT_V(n) asm volatile("s_waitcnt vmcnt(" #n ")" ::: "memory")
#define PG8_WAIT_L(n) asm volatile("s_waitcnt lgkmcnt(" #n ")" ::: "memory")
#define PG8_BAR __builtin_amdgcn_s_barrier()
#define PG8_SCHED __builtin_amdgcn_sched_barrier(0)
    Unit cur, nxt; int ui = 0;
    if (!S.next(0, cur)) return;
    f32x4 acc[2][2][4][2];
#pragma unroll
    for (int a = 0; a < 2; ++a)
#pragma unroll
        for (int b = 0; b < 2; ++b)
#pragma unroll
            for (int m = 0; m < 4; ++m)
#pragma unroll
                for (int n = 0; n < 2; ++n) acc[a][b][m][n] = (f32x4){0.f, 0.f, 0.f, 0.f};
    bf16x8 At[4][2], B0[2][2], B1[2][2];
    const char* cA = (const char*)g.A + (size_t)cur.pm * tstep; const char* cB = (const char*)g.Bt + (size_t)cur.pn * tstep;
    S.a_ready(cur);
    PG8_STAGE(PG8_SB(0, 0), cB, voffB); PG8_STAGE(PG8_SA(0, 0), cA, voffA); PG8_STAGE(PG8_SB(0, 1), cB + hstep, voffB); PG8_STAGE(PG8_SA(0, 1), cA + hstep, voffA);
    if (wr == 1) PG8_BAR;
    PG8_WAIT_V(4); PG8_BAR;
    PG8_STAGE(PG8_SB(1, 0), cB + kstep, voffB); PG8_STAGE(PG8_SA(1, 0), cA + kstep, voffA); PG8_STAGE(PG8_SB(1, 1), cB + hstep + kstep, voffB);
    PG8_WAIT_V(6); PG8_BAR;
    PG8_STAMP();
    for (;;) {
        const bool has_next = S.next(ui + 1, nxt);
        const char* nA = has_next ? (const char*)g.A + (size_t)nxt.pm * tstep : cA; const char* nB = has_next ? (const char*)g.Bt + (size_t)nxt.pn * tstep : cB;
        for (int t = 0; t < nt; t += 2) {
            const bool last = (t == nt - 2);
            const char* a1 = cA + (size_t)(t + 1) * kstep;
            const char* a2 = last ? nA : cA + (size_t)(t + 2) * kstep; const char* b2 = last ? nB : cB + (size_t)(t + 2) * kstep;
            const char* a3 = a2 + kstep; const char* b3 = b2 + kstep;
            if (last && has_next) S.a_ready(nxt);
            PG8_LDB(B0, 0, 0); PG8_SCHED; PG8_LDA(At, 0, 0); PG8_STAGE(PG8_SA(1, 1), a1 + hstep, voffA);
            PG8_WAIT_L(8); PG8_BAR; PG8_WAIT_L(0); PG8_MMA(0, 0, At, B0); PG8_BAR; PG8_SCHED;
            PG8_LDB(B1, 0, 1); PG8_STAGE(PG8_SB(0, 0), b2, voffB);
            PG8_BAR; PG8_WAIT_L(0); PG8_MMA(0, 1, At, B1); PG8_BAR;
            PG8_LDA(At, 0, 1); PG8_STAGE(PG8_SA(0, 0), a2, voffA);
            PG8_BAR; PG8_WAIT_L(0); PG8_MMA(1, 0, At, B0); PG8_BAR; PG8_SCHED;
            PG8_STAGE(PG8_SB(0, 1), b2 + hstep, voffB);
            PG8_WAIT_V(6); PG8_BAR; PG8_MMA(1, 1, At, B1); PG8_BAR;
            PG8_LDB(B0, 1, 0); PG8_SCHED; PG8_LDA(At, 1, 0); PG8_STAGE(PG8_SA(0, 1), a2 + hstep, voffA);
            PG8_WAIT_L(8); PG8_BAR; PG8_WAIT_L(0); PG8_MMA(0, 0, At, B0); PG8_BAR; PG8_SCHED;
            PG8_LDB(B1, 1, 1); PG8_STAGE(PG8_SB(1, 0), b3, voffB);
            PG8_BAR; PG8_WAIT_L(0); PG8_MMA(0, 1, At, B1); PG8_BAR;
            PG8_LDA(At, 1, 1); PG8_STAGE(PG8_SA(1, 0), a3, voffA);
            PG8_BAR; PG8_WAIT_L(0); PG8_MMA(1, 0, At, B0); PG8_BAR; PG8_SCHED;
            PG8_STAGE(PG8_SB(1, 1), b3 + hstep, voffB);
            PG8_WAIT_V(6); PG8_BAR; PG8_MMA(1, 1, At, B1); PG8_BAR;
        }
        PG8_STAMP();
        if constexpr (!Epi::AFTER_DRAIN) { E(acc, cur, wr, wc, fr, fq); S.done(cur); }
        PG8_STAMP();
        if (!has_next) break;
#pragma unroll
        for (int a = 0; a < 2; ++a)
#pragma unroll
            for (int b = 0; b < 2; ++b)
#pragma unroll
                for (int m = 0; m < 4; ++m)
#pragma unroll
                    for (int n = 0; n < 2; ++n) acc[a][b][m][n] = (f32x4){0.f, 0.f, 0.f, 0.f};
        cur = nxt; cA = nA; cB = nB; ++ui;
    }
    PG8_WAIT_V(0);
    if (wr == 0) PG8_BAR;
    PG8_BAR;
    if constexpr (Epi::AFTER_DRAIN) { E.fused(acc, cur, wr, wc, fr, fq, lds, wid, lane); S.done(cur); }
    PG8_STAMP();
    if (STAMP && wid == 0) { stamps[lane] = lane < nts ? (((unsigned long long)(unsigned)ts_hi << 32) | (unsigned)ts_lo) : 0ull;
        if (lane == 62) stamps[62] = rt_entry; if (lane == 63) stamps[63] = (unsigned long long)wall_clock64(); }
#undef PG8_STAMP
#undef PG8_SA
#undef PG8_SB
#undef PG8_STAGE
#undef PG8_LDA
#undef PG8_LDB
#undef PG8_MMA
#undef PG8_WAIT_V
#undef PG8_WAIT_L
#undef PG8_BAR
#undef PG8_SCHED
}
}

struct EpiRowBf16 {
    static constexpr bool PERM = true, AFTER_DRAIN = false;
    u16* O; int ldc;
    DI void operator()(const f32x4 (&acc)[2][2][4][2], const pg8::Unit& u, int wr, int wc, int fr, int fq) const {
        const int row0 = u.pm * 256 + wr * 64 + fr, col0 = u.pn * 256 + wc * 32 + 8 * fq;
#pragma unroll
        for (int ai = 0; ai < 2; ++ai)
#pragma unroll
            for (int m = 0; m < 4; ++m) {
                u16* rowp = O + (size_t)(row0 + ai * 128 + m * 16) * ldc + col0;
#pragma unroll
                for (int bj = 0; bj < 2; ++bj) {
                    const f32x4 v0 = acc[ai][bj][m][0], v1 = acc[ai][bj][m][1];
                    *(u32x4*)(rowp + bj * 128) = (u32x4){cvtpk(v0[0], v0[1]), cvtpk(v0[2], v0[3]), cvtpk(v1[0], v1[1]), cvtpk(v1[2], v1[3])};
                }
            }
    }
};
struct EpiVT {
    static constexpr bool PERM = true, AFTER_DRAIN = false;
    u16* VT;
    DI void operator()(const f32x4 (&acc)[2][2][4][2], const pg8::Unit& u, int wr, int wc, int fr, int fq) const {
        const int ch0 = u.pm * 256 + wr * 64 + fr, tok0 = u.pn * 256 + wc * 32 + 8 * fq;
        const int b = tok0 >> 12, t0 = tok0 & 4095;
#pragma unroll
        for (int ai = 0; ai < 2; ++ai)
#pragma unroll
            for (int m = 0; m < 4; ++m) {
                u16* rowp = VT + ((size_t)b * NVT + ch0 + ai * 128 + m * 16) * SEQ + t0;
#pragma unroll
                for (int bj = 0; bj < 2; ++bj) {
                    const f32x4 v0 = acc[ai][bj][m][0], v1 = acc[ai][bj][m][1];
                    *(u32x4*)(rowp + bj * 128) = (u32x4){cvtpk(v0[0], v0[1]), cvtpk(v0[2], v0[3]), cvtpk(v1[0], v1[1]), cvtpk(v1[2], v1[3])};
                }
            }
    }
};
template <bool FIRST>
struct EpiRes {
    static constexpr bool PERM = true, AFTER_DRAIN = false;
    const float* X; u16* Y; const float* stats; const float* lg; const float* lb; const float* gate;
    DI void operator()(const f32x4 (&acc)[2][2][4][2], const pg8::Unit& u, int wr, int wc, int fr, int fq) const {
        const int row0 = u.pm * 256 + wr * 64 + fr, col0 = u.pn * 256 + wc * 32 + 8 * fq;
        const float* gb = gate + (size_t)(u.pm >> 4) * 3072;
#pragma unroll
        for (int bj = 0; bj < 2; ++bj) {
            const int c = col0 + bj * 128;
            float gp[8], ag[8], ab[8];
#pragma unroll
            for (int n = 0; n < 2; ++n) {
                const f32x4 t = *(const f32x4*)(gb + c + 4 * n);
#pragma unroll
                for (int j = 0; j < 4; ++j) gp[4 * n + j] = 1.f + t[j];
                if (!FIRST) {
                    const f32x4 g4 = *(const f32x4*)(lg + c + 4 * n), b4 = *(const f32x4*)(lb + c + 4 * n);
#pragma unroll
                    for (int j = 0; j < 4; ++j) { ag[4 * n + j] = ALPHA_RES * g4[j]; ab[4 * n + j] = ALPHA_RES * b4[j]; }
                }
            }
            constexpr int GR = 4;
#pragma unroll
            for (int g0 = 0; g0 < 8; g0 += GR) {
                u32x4 yv[GR]; f32x2_t st[GR]; f32x4 x0[GR], x1[GR];
#pragma unroll
                for (int i = 0; i < GR; ++i) {
                    const int ai = (g0 + i) >> 2, m = (g0 + i) & 3;
                    const size_t row = (size_t)(row0 + ai * 128 + m * 16);
                    if (FIRST) { x0[i] = *(const f32x4*)(X + row * 1024 + c); x1[i] = *(const f32x4*)(X + row * 1024 + c + 4); }
                    else { yv[i] = *(const u32x4*)(Y + row * 1024 + c); st[i] = *(const f32x2_t*)(stats + row * 2); }
                }
#pragma unroll
                for (int i = 0; i < GR; ++i) {
                    const int ai = (g0 + i) >> 2, m = (g0 + i) & 3;
                    const size_t row = (size_t)(row0 + ai * 128 + m * 16);
                    float xa[8];
                    if (FIRST) {
#pragma unroll
                        for (int j = 0; j < 4; ++j) { xa[j] = ALPHA_RES * x0[i][j]; xa[4 + j] = ALPHA_RES * x1[i][j]; }
                    } else {
                        const float rs = st[i][1], nm = -st[i][0] * st[i][1];
#pragma unroll
                        for (int q = 0; q < 4; ++q) {
                            xa[2 * q] = fmaf(fmaf(bflo(yv[i][q]), rs, nm), ag[2 * q], ab[2 * q]);
                            xa[2 * q + 1] = fmaf(fmaf(bfhi(yv[i][q]), rs, nm), ag[2 * q + 1], ab[2 * q + 1]);
                        }
                    }
                    float o[8];
#pragma unroll
                    for (int n = 0; n < 2; ++n)
#pragma unroll
                        for (int j = 0; j < 4; ++j) o[4 * n + j] = fmaf(gp[4 * n + j], acc[ai][bj][m][n][j], xa[4 * n + j]);
                    *(u32x4*)(Y + row * 1024 + c) = (u32x4){cvtpk(o[0], o[1]), cvtpk(o[2], o[3]), cvtpk(o[4], o[5]), cvtpk(o[6], o[7])};
                }
            }
        }
    }
};
struct EpiSwiglu {
    static constexpr bool PERM = true, AFTER_DRAIN = false;
    u16* ACT;
    DI void operator()(const f32x4 (&acc)[2][2][4][2], const pg8::Unit& u, int wr, int wc, int fr, int fq) const {
        const int row0 = u.pm * 256 + wr * 64 + fr, j0 = u.pn * 128 + wc * 32 + 8 * fq;
#pragma unroll
        for (int ai = 0; ai < 2; ++ai)
#pragma unroll
            for (int m = 0; m < 4; ++m) {
                float v[8];
#pragma unroll
                for (int n = 0; n < 2; ++n)
#pragma unroll
                    for (int j = 0; j < 4; ++j) v[4 * n + j] = siluf_(acc[ai][0][m][n][j]) * acc[ai][1][m][n][j];
                *(u32x4*)(ACT + (size_t)(row0 + ai * 128 + m * 16) * FF + j0) = (u32x4){cvtpk(v[0], v[1]), cvtpk(v[2], v[3]), cvtpk(v[4], v[5]), cvtpk(v[6], v[7])};
            }
    }
};
struct EpiIn1 {
    static constexpr bool PERM = true, AFTER_DRAIN = false;
    u16* B1; u16* CZ;
    DI void operator()(const f32x4 (&acc)[2][2][4][2], const pg8::Unit& u, int wr, int wc, int fr, int fq) const {
        const int row0 = u.pm * 256 + wr * 64 + fr;
        if (u.pn < 4) {
            const int col0 = u.pn * 256 + wc * 32 + 8 * fq;
#pragma unroll
            for (int ai = 0; ai < 2; ++ai)
#pragma unroll
                for (int m = 0; m < 4; ++m) {
                    u16* rowp = B1 + (size_t)(row0 + ai * 128 + m * 16) * 1024 + col0;
#pragma unroll
                    for (int bj = 0; bj < 2; ++bj) {
                        const f32x4 v0 = acc[ai][bj][m][0], v1 = acc[ai][bj][m][1];
                        *(u32x4*)(rowp + bj * 128) = (u32x4){cvtpk(v0[0], v0[1]), cvtpk(v0[2], v0[3]), cvtpk(v1[0], v1[1]), cvtpk(v1[2], v1[3])};
                    }
                }
        } else {
            const int j0 = (u.pn - 4) * 128 + wc * 32 + 8 * fq;
#pragma unroll
            for (int ai = 0; ai < 2; ++ai)
#pragma unroll
                for (int m = 0; m < 4; ++m) {
                    const f32x4 v0 = acc[ai][0][m][0] * acc[ai][1][m][0], v1 = acc[ai][0][m][1] * acc[ai][1][m][1];
                    *(u32x4*)(CZ + (size_t)(row0 + ai * 128 + m * 16) * 1024 + j0) = (u32x4){cvtpk(v0[0], v0[1]), cvtpk(v0[2], v0[3]), cvtpk(v1[0], v1[1]), cvtpk(v1[2], v1[3])};
                }
        }
    }
};
template <class Epi>
DI void run_gemm(PG8_LAS unsigned char* lds, const u16* A, const u16* Bt, int M, int N, int K, const Epi& E) {
    pg8::Gemm g{A, Bt, M, N, K};
    pg8::StaticOrder S; S.init(M, N, (int)gridDim.x, (int)blockIdx.x);
    pg8::gemm_phase<Epi, pg8::StaticOrder, false>(lds, g, S, E, nullptr);
}

DI void compress_item(const Params& p, int item, char* lds) {
    const int which = item >> 6, g = (item >> 5) & 1, mt = item & 31;
    const int tid = TIDX, lane = tid & 63, w = tid >> 6, wm = w >> 1, wn = w & 1, r = lane & 31, h = lane >> 5;
    const u16* PR = (const u16*)(p.ws + WS_PR);
    const u16* A = PR + (size_t)mt * 128 * 16 * LDP + (which ? 640 : 512) + g * 64;
    const u16* Bt = (const u16*)(p.ws + WS_W1T) + (size_t)which * 128 * 2048;
    f32x16 acc[2][2]; zero_acc(acc);
    gemm_main_pf2<true>(A, 16 * LDP, LDP, Bt, 2048, 32, lds, acc);
    const float* b1p = (const float*)(p.ws + WS_B1P) + which * 16 * 128;
#pragma unroll
    for (int ni = 0; ni < 2; ++ni)
#pragma unroll
        for (int a = 0; a < 4; ++a) {
            const int j0 = wn * 64 + ni * 32 + 8 * a + 4 * h;
            float bias[4] = {0.f, 0.f, 0.f, 0.f};
            for (int c = 0; c < 16; ++c) {
                const f32x4 t = *(const f32x4*)(b1p + c * 128 + j0);
                bias[0] += t[0]; bias[1] += t[1]; bias[2] += t[2]; bias[3] += t[3];
            }
#pragma unroll
            for (int mi = 0; mi < 2; ++mi) {
                const int m = wm * 64 + mi * 32 + r;
                float v[4];
#pragma unroll
                for (int j = 0; j < 4; ++j) v[j] = geluf_(acc[mi][ni][4 * a + j] + bias[j]);
                const int chunk = (j0 >> 3) ^ (m & 15);
                *(u32x2*)(lds + m * 256 + chunk * 16 + (j0 & 7) * 2) = (u32x2){cvtpk(v[0], v[1]), cvtpk(v[2], v[3])};
            }
        }
    __syncthreads();
    const u16* W2 = (const u16*)(p.ws + WS_W2T) + which * 64 * 128;
    f32x16 o2[2];
#pragma unroll
    for (int i = 0; i < 16; ++i) { o2[0][i] = 0.f; o2[1][i] = 0.f; }
    const int mrow = 32 * w + r;
#pragma unroll
    for (int ks = 0; ks < 8; ++ks) {
        const bf16x8 hf = *(const bf16x8*)(lds + mrow * 256 + (((ks * 2 + h) ^ (mrow & 15)) << 4));
#pragma unroll
        for (int et = 0; et < 2; ++et) {
            const bf16x8 wf = *(const bf16x8*)(W2 + (et * 32 + r) * 128 + ks * 16 + 8 * h);
            o2[et] = which ? MFMA(hf, wf, o2[et]) : MFMA(wf, hf, o2[et]);
        }
    }
    const int bg_base = (mt >> 1);
    const int nbase = (mt & 1) * 128 + 32 * w;
    const int kbc = (mt & 1) * 4 + w;
    const size_t fbase = ((size_t)(bg_base * 2 + g) * 8 + kbc) * 2048;
    if (which == 0) {
        u16* kc = (u16*)(p.ws + WS_KCMP) + fbase;
        const bool zero = (kbc == 7) && (r == 31);
#pragma unroll
        for (int et = 0; et < 2; ++et)
#pragma unroll
            for (int a = 0; a < 4; ++a) {
                u32x2 v = (u32x2){cvtpk(o2[et][4 * a], o2[et][4 * a + 1]), cvtpk(o2[et][4 * a + 2], o2[et][4 * a + 3])};
                if (zero) v = (u32x2){0u, 0u};
                *(u32x2*)(kc + ((et * 2 + (a >> 1)) * 64 + (a & 1) * 32 + r) * 8 + 4 * h) = v;
            }
    } else {
        u16* vt = (u16*)(p.ws + WS_VCMPT) + fbase;
#pragma unroll
        for (int et = 0; et < 2; ++et)
#pragma unroll
            for (int a = 0; a < 4; ++a) {
                float v3 = o2[et][4 * a + 3];
                if (kbc == 7 && a == 3 && h == 1) v3 = 0.f;
                *(u32x2*)(vt + (((a >> 1) * 2 + et) * 64 + h * 32 + r) * 8 + 4 * (a & 1)) = (u32x2){cvtpk(o2[et][4 * a], o2[et][4 * a + 1]), cvtpk(o2[et][4 * a + 2], v3)};
            }
    }
    __syncthreads();
}

DI void gmlp_item(const Params& p, int item, char* lds) {
    const int grp = item & 7, chunk = (item >> 3) & 31, b = item >> 8;
    const int tid = TIDX, lane = tid & 63, w = tid >> 6, r = lane & 31, h = lane >> 5;
    const u16* VT = (const u16*)(p.ws + WS_VT) + ((size_t)b * NVT + 256 + grp * 64) * SEQ + chunk * 128;
#pragma unroll
    for (int i = 0; i < 4; ++i) {
        const int id = tid + 256 * i, d = id >> 4, c = id & 15;
        *(u32x4*)(lds + d * 256 + ((c ^ (d & 15)) << 4)) = *(const u32x4*)(VT + (size_t)d * SEQ + c * 8);
    }
    const int nks = 2 * (w + 1);
    bf16x8 wfr[8];
    {
        const u16* Wt = (const u16*)(p.ws + WS_TRIL) + (size_t)grp * 128 * 128 + (32 * w + r) * 128 + 8 * h;
#pragma unroll
        for (int ks = 0; ks < 8; ++ks) wfr[ks] = (ks < nks) ? *(const bf16x8*)(Wt + ks * 16) : (bf16x8){0, 0, 0, 0, 0, 0, 0, 0};
    }
    const int t = 32 * w + r;
    const size_t tok = (size_t)b * SEQ + chunk * 128 + t;
    const float bs = p.gmlp_bs[grp * 128 + t];
    const u16* up = (const u16*)(p.ws + WS_PR) + tok * LDP + 1024 + grp * 64 + 4 * h;
    u32x2 uu[2][4];
#pragma unroll
    for (int dt = 0; dt < 2; ++dt)
#pragma unroll
        for (int a = 0; a < 4; ++a) uu[dt][a] = *(const u32x2*)(up + dt * 32 + 8 * a);
    __syncthreads();
    {
        float* red = (float*)(lds + 16384);
        const int s = tid & 127, dh = tid >> 7;
        float v[32]; float sum = 0.f;
#pragma unroll
        for (int i = 0; i < 32; ++i) {
            const int d = dh * 32 + i;
            const u16 raw = *(const u16*)(lds + d * 256 + ((((s >> 3)) ^ (d & 15)) << 4) + (s & 7) * 2);
            v[i] = geluf_(bf2f(raw)); sum += v[i];
        }
        red[dh * 128 + s] = sum;
        __syncthreads();
        const float mu = (red[s] + red[128 + s]) * (1.f / 64.f);
        float sq = 0.f;
#pragma unroll
        for (int i = 0; i < 32; ++i) { const float dlt = v[i] - mu; sq += dlt * dlt; }
        __syncthreads();
        red[dh * 128 + s] = sq;
        __syncthreads();
        const float rstd = rsqrtf((red[s] + red[128 + s]) * (1.f / 64.f) + 1e-5f);
        const float* ng = p.gmlp_norm_g + grp * 64 + dh * 32;
#pragma unroll
        for (int i = 0; i < 32; ++i) {
            const int d = dh * 32 + i;
            const float y = (v[i] - mu) * rstd * ng[i];
            const unsigned pk = cvtpk(y, 0.f);
            *(u16*)(lds + d * 256 + ((((s >> 3)) ^ (d & 15)) << 4) + (s & 7) * 2) = (u16)(pk & 0xffffu);
        }
    }
    __syncthreads();
    f32x16 x[2];
#pragma unroll
    for (int i = 0; i < 16; ++i) { x[0][i] = 0.f; x[1][i] = 0.f; }
#pragma unroll
    for (int ks = 0; ks < 8; ++ks) {
        if (ks < nks) {
#pragma unroll
            for (int dt = 0; dt < 2; ++dt) {
                const int d = dt * 32 + r;
                const bf16x8 vf = *(const bf16x8*)(lds + d * 256 + (((ks * 2 + h) ^ (d & 15)) << 4));
                x[dt] = MFMA(vf, wfr[ks], x[dt]);
            }
        }
    }
    u16* op = (u16*)(p.ws + WS_MIX) + tok * 1024 + 512 + grp * 64 + 4 * h;
#pragma unroll
    for (int dt = 0; dt < 2; ++dt)
#pragma unroll
        for (int a = 0; a < 4; ++a) {
            const float u0 = geluf_(bflo(uu[dt][a][0])), u1 = geluf_(bfhi(uu[dt][a][0])), u2 = geluf_(bflo(uu[dt][a][1])), u3 = geluf_(bfhi(uu[dt][a][1]));
            *(u32x2*)(op + dt * 32 + 8 * a) = (u32x2){cvtpk(u0 * (x[dt][4 * a] + bs), u1 * (x[dt][4 * a + 1] + bs)), cvtpk(u2 * (x[dt][4 * a + 2] + bs), u3 * (x[dt][4 * a + 3] + bs))};
        }
    __syncthreads();
}


DI void repack_item(const Params& p, int item) {
    const int tid = TIDX, x = tid >> 6, lane = tid & 63, r = lane & 31, h = lane >> 5;
    const int kb0 = (item & 15) * 8, bg = (item >> 4) & 31, tensor = item >> 9, b = bg >> 1, g = bg & 1;
    const size_t dsto = ((((size_t)bg * 128 + kb0) * 4 + x) * 64 + lane) * 8;
    u32x4 v[8];
    if (tensor < 2) {
        const u16* src = (const u16*)(p.ws + WS_PR) + ((size_t)b * SEQ + kb0 * 32 + r) * LDP + (tensor ? 896 : 768) + g * 64 + x * 16 + 8 * h;
#pragma unroll
        for (int i = 0; i < 8; ++i) v[i] = *(const u32x4*)(src + (size_t)i * 32 * LDP);
    } else {
        const int s2 = x >> 1, dt = x & 1;
        const u16* vp = (const u16*)(p.ws + WS_VT) + ((size_t)b * NVT + (tensor == 3 ? 128 : 0) + g * 64 + dt * 32 + r) * SEQ + kb0 * 32 + 16 * s2 + 4 * h;
#pragma unroll
        for (int i = 0; i < 8; ++i) { const u32x2 lo = *(const u32x2*)(vp + i * 32), hi = *(const u32x2*)(vp + i * 32 + 8); v[i] = (u32x4){lo[0], lo[1], hi[0], hi[1]}; }
    }
    u16* dst = (u16*)(p.ws + (tensor == 0 ? WS_KSF : tensor == 1 ? WS_KWF : tensor == 2 ? WS_VSF : WS_VWF)) + dsto;
#pragma unroll
    for (int i = 0; i < 8; ++i) *(u32x4*)(dst + (size_t)i * 2048) = v[i];
}

DI f32x16 qk_tile(const u16* __restrict__ Kb, long ldk, int key0, const bf16x8 (&qf)[4], int r, int h) {
    const u16* kp = Kb + (long)(key0 + r) * ldk + 8 * h;
    f32x16 s;
#pragma unroll
    for (int i = 0; i < 16; ++i) s[i] = 0.f;
#pragma unroll
    for (int ks = 0; ks < 4; ++ks) { const bf16x8 kf = *(const bf16x8*)(kp + ks * 16); s = MFMA(kf, qf[ks], s); }
    return s;
}
DI void pv_tile(const u16* __restrict__ Vt, long ldv, int key0, const float (&pr)[16], f32x16 (&o)[2], int r, int h) {
#pragma unroll
    for (int s2 = 0; s2 < 2; ++s2) {
        const u32x4 pk = (u32x4){cvtpk(pr[8 * s2], pr[8 * s2 + 1]), cvtpk(pr[8 * s2 + 2], pr[8 * s2 + 3]), cvtpk(pr[8 * s2 + 4], pr[8 * s2 + 5]), cvtpk(pr[8 * s2 + 6], pr[8 * s2 + 7])};
        const bf16x8 pb = __builtin_bit_cast(bf16x8, pk);
#pragma unroll
        for (int dt = 0; dt < 2; ++dt) {
            const u16* vp = Vt + (long)(dt * 32 + r) * ldv + key0 + 16 * s2 + 4 * h;
            const u32x2 lo = *(const u32x2*)vp, hi = *(const u32x2*)(vp + 8);
            const bf16x8 vf = __builtin_bit_cast(bf16x8, (u32x4){lo[0], lo[1], hi[0], hi[1]});
            o[dt] = MFMA(vf, pb, o[dt]);
        }
    }
}
struct KVF { bf16x8 k[4]; bf16x8 v[4]; };
DI void load_k(KVF& f, const u16* __restrict__ Kf, const u16* __restrict__ Vf, int kb, int lane) {
    const u16* kp = Kf + (size_t)kb * 2048 + lane * 8;
    const u16* vp = Vf + (size_t)kb * 2048 + lane * 8;
#pragma unroll
    for (int ks = 0; ks < 4; ++ks) f.k[ks] = *(const bf16x8*)(kp + ks * 512);
#pragma unroll
    for (int x = 0; x < 4; ++x) f.v[x] = *(const bf16x8*)(vp + x * 512);
}
template <class VF>
DI void attend_block(const KVF& f, const bf16x8 (&qs)[4], bool masked, VF valid, bool lanesel, bool first, float& m, float& l, f32x16 (&o)[2]) {
    const float NI = -__builtin_inff();
    const float init = lanesel ? -m : NI;
    f32x16 sv;
#pragma unroll
    for (int i = 0; i < 16; ++i) sv[i] = init;
#pragma unroll
    for (int ks = 0; ks < 4; ++ks) sv = MFMA(f.k[ks], qs[ks], sv);
    float s[16];
    if (masked) {
#pragma unroll
        for (int i = 0; i < 16; ++i) s[i] = valid(i) ? sv[i] : NI;
    } else {
#pragma unroll
        for (int i = 0; i < 16; ++i) s[i] = sv[i];
    }
    float mx = s[0];
#pragma unroll
    for (int i = 1; i < 16; ++i) mx = fmaxf(mx, s[i]);
    if (first) {
        mx = fmaxf(mx, __shfl_xor(mx, 32));
        const float d = (mx > NI) ? mx : 0.f;
        m = d;
#pragma unroll
        for (int i = 0; i < 16; ++i) s[i] -= d;
    } else if (__ballot(mx > 8.f)) {
        mx = fmaxf(mx, __shfl_xor(mx, 32));
        const float d = fmaxf(mx, 0.f), al = fexp2(-d);
        l *= al; m += d;
#pragma unroll
        for (int i = 0; i < 16; ++i) { o[0][i] *= al; o[1][i] *= al; s[i] -= d; }
    }
#pragma unroll
    for (int i = 0; i < 16; ++i) s[i] = fexp2(s[i]);
    const bf16x2_t ones = __builtin_bit_cast(bf16x2_t, 0x3f803f80u);
    float ps = 0.f;
#pragma unroll
    for (int s2 = 0; s2 < 2; ++s2) {
        const u32x4 pk = (u32x4){cvtpk(s[8 * s2], s[8 * s2 + 1]), cvtpk(s[8 * s2 + 2], s[8 * s2 + 3]), cvtpk(s[8 * s2 + 4], s[8 * s2 + 5]), cvtpk(s[8 * s2 + 6], s[8 * s2 + 7])};
#pragma unroll
        for (int q = 0; q < 8; ++q) ps += s[8 * s2 + q];
        const bf16x8 pb = __builtin_bit_cast(bf16x8, pk);
#pragma unroll
        for (int dt = 0; dt < 2; ++dt) o[dt] = MFMA(f.v[s2 * 2 + dt], pb, o[dt]);
    }
    l += ps;
}
template <class NextF, class MaskF, class ValidF, class LaneF>
DI void attend_range(const u16* __restrict__ Kf, const u16* __restrict__ Vf, int first, int last, NextF next, MaskF maskedf, ValidF validf, LaneF lanef,
                     const bf16x8 (&qf)[4], int lane, float& m, float& l, f32x16 (&o)[2], const KVF* pre = nullptr) {
    int kb = first;
    if (kb > last) return;
    KVF A, B;
    bool fst = true;
    if (pre) A = *pre; else load_k(A, Kf, Vf, kb, lane);
#pragma unroll 1
    for (;;) {
        int nk = next(kb);
        load_k(B, Kf, Vf, nk <= last ? nk : last, lane);
        attend_block(A, qf, maskedf(kb), [&](int i) { return validf(kb, i); }, lanef(kb), fst, m, l, o);
        fst = false;
        if (nk > last) break;
        kb = nk;
        nk = next(kb);
        load_k(A, Kf, Vf, nk <= last ? nk : last, lane);
        attend_block(B, qf, maskedf(kb), [&](int i) { return validf(kb, i); }, lanef(kb), false, m, l, o);
        if (nk > last) break;
        kb = nk;
    }
}

DI void nsa_item(const Params& p, int item, char* lds) {
    const int qt = 127 - (item >> 5), bg = item & 31, b = bg >> 1, g = bg & 1;
    int tid = TIDX;
    asm volatile("" : "+v"(tid));
    const int lane = tid & 63, w = tid >> 6, r = lane & 31, h = lane >> 5;
    const int q0 = qt * 32, hq = g * 4 + w, tq = q0 + r;
    const size_t tokb = (size_t)b * SEQ;
    const u16* PR = (const u16*)(p.ws + WS_PR);
    const u16* VT = (const u16*)(p.ws + WS_VT);
    const float SC = 0.125f * 1.4426950408889634f;
    const float NINF = -__builtin_inff();
    bf16x8 qf[4];
    {
        const u16* qp = PR + (tokb + tq) * LDP + hq * 64 + 8 * h;
#pragma unroll
        for (int ks = 0; ks < 4; ++ks) qf[ks] = *(const bf16x8*)(qp + ks * 16);
    }
    float* slab = (float*)lds;
    unsigned long long* masks = (unsigned long long*)(lds + 33280);
    unsigned* uni = (unsigned*)(lds + 33280 + 256);

    float* stash = (float*)(lds + 34816) + w * 2048 + lane;
    {
        const u16* Kc = (const u16*)(p.ws + WS_KCMP) + (size_t)(b * 2 + g) * 8 * 2048;
        const u16* Vc = (const u16*)(p.ws + WS_VCMPT) + (size_t)(b * 2 + g) * 8 * 2048;
        const int nkb = (q0 >> 9) + 1;
        float m = -1e30f, l = 0.f;
        auto qk = [&](const KVF& f) { f32x16 sv;
#pragma unroll
            for (int i = 0; i < 16; ++i) sv[i] = 0.f;
#pragma unroll
            for (int ks = 0; ks < 4; ++ks) sv = MFMA(f.k[ks], qf[ks], sv);
            return sv; };
        auto pass1 = [&](const KVF& f, int kb) {
            const f32x16 sv = qk(f);
            float s[16];
#pragma unroll
            for (int i = 0; i < 16; ++i) { const int n = kb * 32 + crow(i, h); s[i] = (16 * n + 31 <= tq) ? sv[i] * SC : NINF; }
            float mx = s[0];
#pragma unroll
            for (int i = 1; i < 16; ++i) mx = fmaxf(mx, s[i]);
            mx = fmaxf(mx, __shfl_xor(mx, 32));
            const float mn = fmaxf(m, mx);
            float ps = 0.f;
#pragma unroll
            for (int i = 0; i < 16; ++i) ps += fexp2(s[i] - mn);
            l = l * fexp2(m - mn) + ps; m = mn;
        };
        {
            KVF A, B;
            load_k(A, Kc, Vc, 0, lane);
#pragma unroll 1
            for (int kb = 0; kb < nkb; kb += 2) {
                load_k(B, Kc, Vc, kb + 1 < nkb ? kb + 1 : nkb - 1, lane);
                pass1(A, kb);
                if (kb + 1 >= nkb) break;
                load_k(A, Kc, Vc, kb + 2 < nkb ? kb + 2 : nkb - 1, lane);
                pass1(B, kb + 1);
            }
        }
        l += __shfl_xor(l, 32);
        const float inv = (l > 0.f) ? 1.f / l : 0.f;
        f32x16 oc[2];
#pragma unroll
        for (int i = 0; i < 16; ++i) { oc[0][i] = 0.f; oc[1][i] = 0.f; }
        float carry = 0.f;
        float* myslab = slab + (w * 32 + r) * 65;
        auto pass2 = [&](const KVF& f, int kb) {
            const f32x16 sv = qk(f);
            float pr[16];
#pragma unroll
            for (int i = 0; i < 16; ++i) { const int n = kb * 32 + crow(i, h); pr[i] = (16 * n + 31 <= tq) ? fexp2(sv[i] * SC - m) * inv : 0.f; }
            float xs[4];
#pragma unroll
            for (int a = 0; a < 4; ++a) xs[a] = __shfl_xor(pr[4 * a + 3], 32);
#pragma unroll
            for (int a = 0; a < 4; ++a) {
                const float sum = pr[4 * a] + pr[4 * a + 1] + pr[4 * a + 2] + pr[4 * a + 3];
                const float prev = h ? xs[a] : (a == 0 ? carry : xs[a > 0 ? a - 1 : 0]);
                myslab[8 * kb + 2 * a + h] = sum + prev;
            }
            carry = xs[3];
#pragma unroll
            for (int s2 = 0; s2 < 2; ++s2) {
                const u32x4 pk = (u32x4){cvtpk(pr[8 * s2], pr[8 * s2 + 1]), cvtpk(pr[8 * s2 + 2], pr[8 * s2 + 3]), cvtpk(pr[8 * s2 + 4], pr[8 * s2 + 5]), cvtpk(pr[8 * s2 + 6], pr[8 * s2 + 7])};
                const bf16x8 pb = __builtin_bit_cast(bf16x8, pk);
#pragma unroll
                for (int dt = 0; dt < 2; ++dt) oc[dt] = MFMA(f.v[s2 * 2 + dt], pb, oc[dt]);
            }
        };
        {
            KVF A, B;
            load_k(A, Kc, Vc, 0, lane);
#pragma unroll 1
            for (int kb = 0; kb < nkb; kb += 2) {
                load_k(B, Kc, Vc, kb + 1 < nkb ? kb + 1 : nkb - 1, lane);
                pass2(A, kb);
                if (kb + 1 >= nkb) break;
                load_k(A, Kc, Vc, kb + 2 < nkb ? kb + 2 : nkb - 1, lane);
                pass2(B, kb + 1);
            }
        }
#pragma unroll 1
        for (int kb = nkb; kb < 8; ++kb) {
#pragma unroll
            for (int a = 0; a < 4; ++a) myslab[8 * kb + 2 * a + h] = 0.f;
        }
        const u16* gp = PR + (tokb + tq) * LDP + 1536 + hq * 3;
        const float g0 = sigmoidf_(bf2f(gp[0]));
#pragma unroll
        for (int i = 0; i < 16; ++i) { stash[i * 64] = g0 * oc[0][i]; stash[(16 + i) * 64] = g0 * oc[1][i]; }
    }
    KVF selpre;
    load_k(selpre, (const u16*)(p.ws + WS_KSF) + (size_t)(b * 2 + g) * 128 * 2048, (const u16*)(p.ws + WS_VSF) + (size_t)(b * 2 + g) * 128 * 2048, 0, lane);
    __syncthreads();
    for (int e = tid; e < 2048; e += 256) {
        const int q = e >> 6, j = e & 63;
        const float v = slab[(0 * 32 + q) * 65 + j] + slab[(1 * 32 + q) * 65 + j] + slab[(2 * 32 + q) * 65 + j] + slab[(3 * 32 + q) * 65 + j];
        const int t = q0 + q, cur = t >> 6;
        const bool forced = (j == 0) | (j == cur) | (j == cur - 1);
        const bool valid = (j * 64 <= t);
        const float vv = forced ? 1e4f : v;
        const unsigned key = (forced || valid) ? ((((__float_as_uint(vv) >> 6) + 1u) << 6) | (unsigned)(63 - j)) : (unsigned)(63 - j);
        slab[q * 65 + j] = __uint_as_float(key);
    }
    if (tid == 0) { uni[0] = 0u; uni[1] = 0u; uni[2] = 0xffffffffu; uni[3] = 0xffffffffu; }
    __syncthreads();
#pragma unroll 1
    for (int qq = 0; qq < 8; ++qq) {
        const int q = w * 8 + qq;
        const unsigned key = __float_as_uint(slab[q * 65 + lane]);
        unsigned T = 0u;
#pragma unroll
        for (int bit = 30; bit >= 0; --bit) {
            const unsigned cand = T | (1u << bit);
            if (__builtin_popcountll(__ballot(key >= cand)) >= 16) T = cand;
        }
        const unsigned long long mk = __ballot(key >= T);
        if (lane == 0) { masks[q] = mk; atomicOr(&uni[0], (unsigned)mk); atomicOr(&uni[1], (unsigned)(mk >> 32)); atomicAnd(&uni[2], (unsigned)mk); atomicAnd(&uni[3], (unsigned)(mk >> 32)); }
    }
    __syncthreads();
    bf16x8 qs[4];
#pragma unroll
    for (int ks = 0; ks < 4; ++ks) {
        const u32x4 t = __builtin_bit_cast(u32x4, qf[ks]); u32x4 o4;
#pragma unroll
        for (int q = 0; q < 4; ++q) o4[q] = cvtpk(bflo(t[q]) * SC, bfhi(t[q]) * SC);
        qs[ks] = __builtin_bit_cast(bf16x8, o4);
    }
    const unsigned long long mymask = masks[r];
    const unsigned long long umask = ((unsigned long long)(unsigned)__builtin_amdgcn_readfirstlane((int)uni[1]) << 32) | (unsigned)__builtin_amdgcn_readfirstlane((int)uni[0]);
    const unsigned long long amask = ((unsigned long long)(unsigned)__builtin_amdgcn_readfirstlane((int)uni[3]) << 32) | (unsigned)__builtin_amdgcn_readfirstlane((int)uni[2]);
    {
        const u16* Ks = (const u16*)(p.ws + WS_KSF) + (size_t)(b * 2 + g) * 128 * 2048;
        const u16* VsT = (const u16*)(p.ws + WS_VSF) + (size_t)(b * 2 + g) * 128 * 2048;
        f32x16 o[2];
#pragma unroll
        for (int i = 0; i < 16; ++i) { o[0][i] = 0.f; o[1][i] = 0.f; }
        float m = 0.f, l = 0.f;
        attend_range(Ks, VsT, 0, qt,
            [&](int kb) { int n = kb + 1; const int j = n >> 1; const unsigned long long rest = umask >> j; if (rest == 0ull) return qt + 1; const int sk = __builtin_ctzll(rest); if (sk > 0) n = (j + sk) * 2; return n; },
            [&](int kb) { return kb == qt; },
            [&](int kb, int i) { return kb * 32 + crow(i, h) <= tq; },
            [&](int kb) { return (bool)((mymask >> (kb >> 1)) & 1ull); },
            qs, lane, m, l, o, &selpre);
        l += __shfl_xor(l, 32);
        const u16* gp = PR + (tokb + tq) * LDP + 1536 + hq * 3;
        const float g1 = sigmoidf_(bf2f(gp[1])) * ((l > 0.f) ? 1.f / l : 0.f);
#pragma unroll
        for (int i = 0; i < 16; ++i) { stash[i * 64] += g1 * o[0][i]; stash[(16 + i) * 64] += g1 * o[1][i]; }
    }
    f32x16 fin[2];
    {
        const u16* Kw = (const u16*)(p.ws + WS_KWF) + (size_t)(b * 2 + g) * 128 * 2048;
        const u16* VwT = (const u16*)(p.ws + WS_VWF) + (size_t)(b * 2 + g) * 128 * 2048;
        f32x16 o[2];
#pragma unroll
        for (int i = 0; i < 16; ++i) { o[0][i] = 0.f; o[1][i] = 0.f; }
        float m = 0.f, l = 0.f;
        const int kb0 = (qt - 16 > 0) ? qt - 16 : 0;
        attend_range(Kw, VwT, kb0, qt,
            [&](int kb) { return kb + 1; },
            [&](int kb) { return (kb == qt) || (kb == qt - 16); },
            [&](int kb, int i) { const int key = kb * 32 + crow(i, h); return (key <= tq) && (key + 512 > tq); },
            [&](int kb) { return true; },
            qs, lane, m, l, o);
        l += __shfl_xor(l, 32);
        const u16* gp = PR + (tokb + tq) * LDP + 1536 + hq * 3;
        const float g2 = sigmoidf_(bf2f(gp[2])) * ((l > 0.f) ? 1.f / l : 0.f);
#pragma unroll
        for (int i = 0; i < 16; ++i) { fin[0][i] = stash[i * 64] + g2 * o[0][i]; fin[1][i] = stash[(16 + i) * 64] + g2 * o[1][i]; }
    }
    u16* op = (u16*)(p.ws + WS_MIX) + (tokb + tq) * 1024 + hq * 64 + 4 * h;
#pragma unroll
    for (int dt = 0; dt < 2; ++dt)
#pragma unroll
        for (int a = 0; a < 4; ++a)
            *(u32x2*)(op + dt * 32 + 8 * a) = (u32x2){cvtpk(fin[dt][4 * a], fin[dt][4 * a + 1]), cvtpk(fin[dt][4 * a + 2], fin[dt][4 * a + 3])};
}

template <bool LAST>
DI void phase_ln(const Params& p, int k) {
    const u16* Y = (const u16*)(p.ws + WS_XY);
    float* stats = (float*)(p.ws + WS_STATS);
    u16* H = (u16*)(p.ws + WS_H);
    int lane = TIDX & 63; const int w = TIDX >> 6;
    asm volatile("" : "+v"(lane));
    const int col = lane * 16;
    const int nwaves = VGRD * 4, rpw = NT_TOK / nwaves;
    const int wid = VBLK * 4 + w;
    float A[16], Bc[16];
    {
        const float* lg = p.ln_g + k * 1024 + col; const float* lb = p.ln_b + k * 1024 + col;
        const int b = (wid * rpw) >> 12;
        const float* mb = (const float*)(p.ws + WS_MOD) + (size_t)(k + 1) * 16 * 3072 + (size_t)b * 3072 + col;
#pragma unroll
        for (int i = 0; i < 4; ++i) {
            const f32x4 gg = *(const f32x4*)(lg + 4 * i), bb = *(const f32x4*)(lb + 4 * i);
            f32x4 sh = (f32x4){0.f, 0.f, 0.f, 0.f}, sc = (f32x4){0.f, 0.f, 0.f, 0.f};
            if (!LAST) { sh = *(const f32x4*)(mb + 4 * i); sc = *(const f32x4*)(mb + 1024 + 4 * i); }
#pragma unroll
            for (int j = 0; j < 4; ++j) { A[4 * i + j] = gg[j] * (sc[j] + 1.f); Bc[4 * i + j] = bb[j] * (sc[j] + 1.f) + sh[j]; }
        }
    }
    for (int r0 = 0; r0 < rpw; r0 += 4) {
        u32x4 ra[4], rb[4];
#pragma unroll
        for (int q = 0; q < 4; ++q) { const u16* yr = Y + (size_t)(wid * rpw + r0 + q) * 1024 + col; ra[q] = *(const u32x4*)yr; rb[q] = *(const u32x4*)(yr + 8); }
#pragma unroll
        for (int q = 0; q < 4; ++q) {
            const int row = wid * rpw + r0 + q;
            float v[16];
#pragma unroll
            for (int t = 0; t < 4; ++t) { v[2 * t] = bflo(ra[q][t]); v[2 * t + 1] = bfhi(ra[q][t]); v[8 + 2 * t] = bflo(rb[q][t]); v[8 + 2 * t + 1] = bfhi(rb[q][t]); }
            float sum = 0.f;
#pragma unroll
            for (int j = 0; j < 16; ++j) sum += v[j];
            const float mu = wave_sum(sum) * (1.f / 1024.f);
            float sq = 0.f;
#pragma unroll
            for (int j = 0; j < 16; ++j) { const float d = v[j] - mu; sq += d * d; }
            const float rstd = rsqrtf(wave_sum(sq) * (1.f / 1024.f) + 1e-5f);
            if (!LAST && lane == 0) *(f32x2_t*)(stats + (size_t)row * 2) = (f32x2_t){mu, rstd};
            float y[16];
#pragma unroll
            for (int j = 0; j < 16; ++j) y[j] = (v[j] - mu) * rstd * A[j] + Bc[j];
            if (LAST) {
#pragma unroll
                for (int i = 0; i < 4; ++i) *(f32x4*)(p.out + (size_t)row * 1024 + col + 4 * i) = (f32x4){y[4 * i], y[4 * i + 1], y[4 * i + 2], y[4 * i + 3]};
            } else {
                u16* hp = H + (size_t)row * 1024 + col;
                *(u32x4*)hp = (u32x4){cvtpk(y[0], y[1]), cvtpk(y[2], y[3]), cvtpk(y[4], y[5]), cvtpk(y[6], y[7])};
                *(u32x4*)(hp + 8) = (u32x4){cvtpk(y[8], y[9]), cvtpk(y[10], y[11]), cvtpk(y[12], y[13]), cvtpk(y[14], y[15])};
            }
        }
    }
}

DI void conv_chunk(const Params& p, u16* G, size_t idx, const u32x4& z0, const u32x4& z1, const u32x4& z2, const u32x4& bb) {
    const int col = (int)(idx & 1023);
    const float* cw = p.odd_conv_w + col;
    float o[8];
#pragma unroll
    for (int j = 0; j < 4; ++j) {
        const int c0 = 2 * j, c1 = 2 * j + 1;
        const float y0 = bflo(z2[j]) * cw[c0] + bflo(z1[j]) * cw[1024 + c0] + bflo(z0[j]) * cw[2048 + c0];
        const float y1 = bfhi(z2[j]) * cw[c1] + bfhi(z1[j]) * cw[1024 + c1] + bfhi(z0[j]) * cw[2048 + c1];
        o[c0] = bflo(bb[j]) * y0; o[c1] = bfhi(bb[j]) * y1;
    }
    *(u32x4*)(G + idx) = (u32x4){cvtpk(o[0], o[1]), cvtpk(o[2], o[3]), cvtpk(o[4], o[5]), cvtpk(o[6], o[7])};
}
DI void conv_chunk_w(u16* G, size_t idx, const u32x4& z0, const u32x4& z1, const u32x4& z2, const u32x4& bb, const float (&cw)[24]) {
    float o[8];
#pragma unroll
    for (int j = 0; j < 4; ++j) {
        const int c0 = 2 * j, c1 = 2 * j + 1;
        const float y0 = bflo(z2[j]) * cw[c0] + bflo(z1[j]) * cw[8 + c0] + bflo(z0[j]) * cw[16 + c0];
        const float y1 = bfhi(z2[j]) * cw[c1] + bfhi(z1[j]) * cw[8 + c1] + bfhi(z0[j]) * cw[16 + c1];
        o[c0] = bflo(bb[j]) * y0; o[c1] = bfhi(bb[j]) * y1;
    }
    *(u32x4*)(G + idx) = (u32x4){cvtpk(o[0], o[1]), cvtpk(o[2], o[3]), cvtpk(o[4], o[5]), cvtpk(o[6], o[7])};
}
DI void phase_conv(const Params& p) {
    const u16* B1 = (const u16*)(p.ws + WS_B1);
    const u16* CZ = (const u16*)(p.ws + WS_CZ);
    u16* G = (u16*)(p.ws + WS_MIX);
    const size_t n8 = (size_t)NT_TOK * 1024 / 8;
    const size_t stride = (size_t)VGRD * 256;
    const u32x4 zero4 = (u32x4){0u, 0u, 0u, 0u};
    size_t e = (size_t)VBLK * 256 + TIDX;
    float cwv[24];
    const bool fixedcol = ((stride * 8) & 1023) == 0;
    {
        const float* cw = p.odd_conv_w + (int)((e * 8) & 1023);
#pragma unroll
        for (int t3 = 0; t3 < 3; ++t3)
#pragma unroll
            for (int j = 0; j < 8; ++j) cwv[t3 * 8 + j] = cw[t3 * 1024 + j];
    }
    for (; fixedcol && e + 3 * stride < n8; e += 4 * stride) {
        u32x4 z0[4], z1[4], z2[4], bb[4];
#pragma unroll
        for (int k = 0; k < 4; ++k) {
            const size_t idx = (e + k * stride) * 8; const int t = (int)((idx >> 10) & 4095);
            z0[k] = *(const u32x4*)(CZ + idx);
            z1[k] = (t >= 1) ? *(const u32x4*)(CZ + idx - 1024) : zero4;
            z2[k] = (t >= 2) ? *(const u32x4*)(CZ + idx - 2048) : zero4;
            bb[k] = *(const u32x4*)(B1 + idx);
        }
#pragma unroll
        for (int k = 0; k < 4; ++k) conv_chunk_w(G, (e + k * stride) * 8, z0[k], z1[k], z2[k], bb[k], cwv);
    }
    for (; e < n8; e += stride) {
        const size_t idx = e * 8; const int t = (int)((idx >> 10) & 4095);
        const u32x4 z0 = *(const u32x4*)(CZ + idx);
        const u32x4 z1 = (t >= 1) ? *(const u32x4*)(CZ + idx - 1024) : zero4;
        const u32x4 z2 = (t >= 2) ? *(const u32x4*)(CZ + idx - 2048) : zero4;
        const u32x4 bb = *(const u32x4*)(B1 + idx);
        conv_chunk(p, G, idx, z0, z1, z2, bb);
    }
}

#define XB_TMO      128
#define XB_XCNT(j)  (256  + 64 * (j))
#define XB_XSUB(j)  (1280 + 64 * (j))
#define XB_XGEN(j)  (2304 + 64 * (j))
#define XB_TOP      3328
#define XB_TOPGEN   3392
#define XCD_BAR_WORDS 3456
#define XB_SPIN_CAP (1u << 18)
#define LAS __attribute__((address_space(3)))

__device__ __forceinline__ unsigned xb_ld(unsigned* p)              { return __hip_atomic_load(p, __ATOMIC_RELAXED, __HIP_MEMORY_SCOPE_AGENT); }
__device__ __forceinline__ unsigned xb_add(unsigned* p, unsigned v) { return __hip_atomic_fetch_add(p, v, __ATOMIC_RELAXED, __HIP_MEMORY_SCOPE_AGENT); }
__device__ __forceinline__ unsigned xb_xcc_id() { return (unsigned)__builtin_amdgcn_s_getreg((3 << 11) | 20) & 0xFu; }
#define XB_SPIN(cond, bar) do { unsigned _sp = 0; while (cond) { __builtin_amdgcn_s_sleep(1); \
    if ((++_sp & 255u) == 0u) { if (xb_ld(&(bar)[XB_TMO])) break; if (_sp > XB_SPIN_CAP) { atomicAdd(&(bar)[XB_TMO], 1u); break; } } } } while (0)

struct XcdBarrier {
    unsigned* bar; unsigned x;
    volatile LAS unsigned* st;
};

__device__ __forceinline__ XcdBarrier xcd_barrier_post(unsigned* bar, volatile LAS unsigned* st) {
    XcdBarrier b; b.bar = bar; b.x = xb_xcc_id(); b.st = st;
    if (threadIdx.x == 0) (void)xb_add(&bar[XB_XCNT(b.x)], 1u);
    return b;
}
__device__ __forceinline__ void xcd_barrier_complete(unsigned* bar, unsigned x, unsigned& nloc, unsigned& nx) {
    const unsigned G = gridDim.x * gridDim.y * gridDim.z;
    unsigned sum, cnt, mine, sp = 0u;
    for (;;) {
        sum = 0u; cnt = 0u; mine = 0u;
#pragma unroll
        for (unsigned j = 0; j < 16; ++j) { const unsigned c = xb_ld(&bar[XB_XCNT(j)]); sum += c; cnt += (c > 0u) ? 1u : 0u; mine = (j == x) ? c : mine; }
        if (sum == G) break;
        __builtin_amdgcn_s_sleep(1);
        if ((++sp & 255u) == 0u) { if (xb_ld(&bar[XB_TMO])) break; if (sp > XB_SPIN_CAP) { atomicAdd(&bar[XB_TMO], 1u); break; } }
    }
    nloc = mine > 0u ? mine : 1u; nx = cnt > 0u ? cnt : 1u;
}

__device__ __forceinline__ void xcd_barrier(const XcdBarrier& b) {
    asm volatile("s_waitcnt vmcnt(0)" ::: "memory");
    __syncthreads();
    if (threadIdx.x == 0) {
        unsigned* bar = b.bar;
        __builtin_amdgcn_s_waitcnt(0);
        unsigned nloc = b.st[0], nx = b.st[1];
        if (nloc == 0u) { xcd_barrier_complete(bar, b.x, nloc, nx); b.st[0] = nloc; b.st[1] = nx; }
        const unsigned old = xb_add(&bar[XB_XSUB(b.x)], 1u);
        const unsigned gen = old / nloc;
        if (old + 1u == (gen + 1u) * nloc) {
            __builtin_amdgcn_fence(__ATOMIC_RELEASE, "agent");
            asm volatile("s_waitcnt vmcnt(0)" ::: "memory");
            const unsigned og = xb_add(&bar[XB_TOP], 1u);
            const unsigned tg = og / nx;
            if (og + 1u == (tg + 1u) * nx) xb_add(&bar[XB_TOPGEN], 1u);
            else XB_SPIN(xb_ld(&bar[XB_TOPGEN]) == tg, bar);
            __builtin_amdgcn_fence(__ATOMIC_ACQUIRE, "agent");
            xb_add(&bar[XB_XGEN(b.x)], 1u);
            asm volatile("s_waitcnt vmcnt(0)" ::: "memory");
        } else {
            XB_SPIN(xb_ld(&bar[XB_XGEN(b.x)]) == gen, bar);
            __builtin_amdgcn_fence(__ATOMIC_ACQUIRE, "agent");
            asm volatile("s_waitcnt vmcnt(0)" ::: "memory");
        }
    }
    __syncthreads();
}

constexpr int HALF_LDS = 67584;
constexpr int LDS_BYTES = 2 * HALF_LDS + 16;
__global__ void __launch_bounds__(512, 2) fwd_megakernel(Params p) {
    extern __shared__ __attribute__((aligned(16))) unsigned char shm[];
    PG8_LAS unsigned char* glds = (PG8_LAS unsigned char*)shm;
    char* lds = (char*)shm + __builtin_amdgcn_readfirstlane((int)(threadIdx.x >> 8)) * HALF_LDS;
    cg::grid_group grid = cg::this_grid();
    volatile LAS unsigned* bst = (volatile LAS unsigned*)(glds + 2 * HALF_LDS);
    if (threadIdx.x == 0) { bst[0] = 0u; bst[1] = 0u; }
    if (blockIdx.x == 0) for (int i = threadIdx.x; i < XCD_BAR_WORDS; i += 512) ((unsigned*)(p.ws + WS_BAR))[i] = 0u;
    __syncthreads();
    unsigned char* ws = p.ws;
    const float* modp = (const float*)(ws + WS_MOD);
    u16* YB = (u16*)(ws + WS_XY);
    const float* stp = (const float*)(ws + WS_STATS);
    const u16* H = (const u16*)(ws + WS_H);
    phase0<0>(p, lds);
    grid.sync();
    const XcdBarrier xb = xcd_barrier_post((unsigned*)(p.ws + WS_BAR), bst);
    phase0<1>(p, lds);
    phase_mod_x(p);
    xcd_barrier(xb);
    run_gemm(glds, H, (const u16*)(ws + WS_WT_IN0), NT_TOK, 1792, 1024, EpiRowBf16{(u16*)(ws + WS_PR), LDP});
    run_gemm(glds, (const u16*)(ws + WS_WT_IN0) + (size_t)1792 * 1024, H, NVT, NT_TOK, 1024, EpiVT{(u16*)(ws + WS_VT)});
    xcd_barrier(xb);
    if (VBLK < 128) {
        compress_item(p, VBLK, lds);
        for (int it = VBLK; it < 512; it += 128) gmlp_item(p, it, lds);
    } else {
        for (int it = 512 + VBLK - 128; it < 4096 + 2048; it += VGRD - 128) {
            if (it < 4096) gmlp_item(p, it, lds); else repack_item(p, it - 4096);
        }
    }
    xcd_barrier(xb);
    for (int it0 = 0, rnd = 0; it0 < 4096; it0 += VGRD, ++rnd) {
        const int it = it0 + ((rnd & 1) ? (VGRD - 1 - VBLK) ^ 1 : VBLK);
        if (it < 4096) nsa_item(p, it, lds);
        __syncthreads();
    }
    xcd_barrier(xb);
    run_gemm(glds, (const u16*)(ws + WS_MIX), (const u16*)(ws + WS_WT_OUT0), NT_TOK, 1024, 1024, EpiRes<true>{p.x, YB, stp, p.ln_g, p.ln_b, modp + 0 * 16 * 3072 + 2048});
    xcd_barrier(xb);
    phase_ln<false>(p, 0);
    xcd_barrier(xb);
    run_gemm(glds, H, (const u16*)(ws + WS_WT_FI0), NT_TOK, 2 * FF, 1024, EpiSwiglu{(u16*)(ws + WS_ACT)});
    xcd_barrier(xb);
    run_gemm(glds, (const u16*)(ws + WS_ACT), (const u16*)(ws + WS_WT_FO0), NT_TOK, 1024, FF, EpiRes<false>{p.x, YB, stp, p.ln_g + 0 * 1024, p.ln_b + 0 * 1024, modp + 1 * 16 * 3072 + 2048});
    xcd_barrier(xb);
    phase_ln<false>(p, 1);
    xcd_barrier(xb);
    run_gemm(glds, H, (const u16*)(ws + WS_WT_IN1), NT_TOK, 3072, 1024, EpiIn1{(u16*)(ws + WS_B1), (u16*)(ws + WS_CZ)});
    xcd_barrier(xb);
    phase_conv(p);
    xcd_barrier(xb);
    run_gemm(glds, (const u16*)(ws + WS_MIX), (const u16*)(ws + WS_WT_OUT1), NT_TOK, 1024, 1024, EpiRes<false>{p.x, YB, stp, p.ln_g + 1 * 1024, p.ln_b + 1 * 1024, modp + 2 * 16 * 3072 + 2048});
    xcd_barrier(xb);
    phase_ln<false>(p, 2);
    xcd_barrier(xb);
    run_gemm(glds, H, (const u16*)(ws + WS_WT_FI1), NT_TOK, 2 * FF, 1024, EpiSwiglu{(u16*)(ws + WS_ACT)});
    xcd_barrier(xb);
    run_gemm(glds, (const u16*)(ws + WS_ACT), (const u16*)(ws + WS_WT_FO1), NT_TOK, 1024, FF, EpiRes<false>{p.x, YB, stp, p.ln_g + 2 * 1024, p.ln_b + 2 * 1024, modp + 3 * 16 * 3072 + 2048});
    xcd_barrier(xb);
    phase_ln<true>(p, 3);
}

extern "C" void kernel_launch(void* const* d_in, const int* in_sizes, int n_in, void* d_out, int out_size, void* d_ws, size_t ws_size,
                              hipStream_t stream) {
    static int grid_blocks = 0;
    if (!grid_blocks) {
        int dev = 0, cus = 0, per_cu = 0;
        (void)hipGetDevice(&dev);
        (void)hipDeviceGetAttribute(&cus, hipDeviceAttributeMultiprocessorCount, dev);
        (void)hipFuncSetAttribute((const void*)fwd_megakernel, hipFuncAttributeMaxDynamicSharedMemorySize, LDS_BYTES);
        (void)hipOccupancyMaxActiveBlocksPerMultiprocessor(&per_cu, fwd_megakernel, 512, LDS_BYTES);
        if (per_cu < 1) fprintf(stderr, "kernel_launch: occupancy query says %d blocks/CU\n", per_cu);
        grid_blocks = cus;
        if (ws_size < WS_END) fprintf(stderr, "kernel_launch: workspace too small: %zu < %zu\n", ws_size, (size_t)WS_END);
    }
    Params p{};
    p.x = (const float*)d_in[0]; p.c = (const float*)d_in[1]; p.ada_w = (const float*)d_in[2]; p.ada_b = (const float*)d_in[3];
    p.ln_g = (const float*)d_in[4]; p.ln_b = (const float*)d_in[5]; p.even_w_in = (const float*)d_in[6]; p.cmp_pos = (const float*)d_in[7];
    p.cmp_w1 = (const float*)d_in[8]; p.cmp_w2 = (const float*)d_in[9]; p.gmlp_norm_g = (const float*)d_in[10]; p.gmlp_ws = (const float*)d_in[11];
    p.gmlp_bs = (const float*)d_in[12]; p.even_w_out = (const float*)d_in[13]; p.odd_w_in = (const float*)d_in[14]; p.odd_conv_w = (const float*)d_in[15];
    p.odd_w_out = (const float*)d_in[16]; p.ffn_w_in = (const float*)d_in[17]; p.ffn_w_out = (const float*)d_in[18];
    p.out = (float*)d_out; p.ws = (unsigned char*)d_ws;
    void* args[] = {&p};
    hipError_t e = hipLaunchCooperativeKernel((void*)fwd_megakernel, dim3(grid_blocks), dim3(512), args, LDS_BYTES, stream);
    if (e != hipSuccess) fprintf(stderr, "cooperative launch failed: %s (grid %d)\n", hipGetErrorString(e), grid_blocks);
}
```
